# Optimizing an MI355X kernel written in HIP

```python
import math
import jax, jax.numpy as jnp
from jax import lax
import numpy as np

D_MODEL = 1024
BATCH = 8
SEQ = 2048
DEPTH = 1

MEM_LEN = 256
D_MIX = D_MODEL
D_SSD = D_MIX // 2
SSD_HEAD_DIM = 64
SSD_HEADS = D_SSD // SSD_HEAD_DIM
SSD_GROUPS = 2
SSD_STATE = 128
CONV_WIDTH = 4
CHUNK = 128
D_XBC = D_SSD + 2 * SSD_GROUPS * SSD_STATE
D_DIFF = D_MIX - D_SSD
DIFF_HEAD_DIM = 64
DIFF_HEADS = D_DIFF // (2 * DIFF_HEAD_DIM)
Q_BLOCK = 128
ROPE_THETA = 10000.0
D_IN = D_SSD + D_XBC + SSD_HEADS + 3 * D_DIFF
MEM_HEADS = 4
MEM_HEAD_DIM = D_MODEL // MEM_HEADS
D_FF = 4 * D_MODEL
NORM_EPS = 1e-6

kernel_name = "hybrid_ssd_diffattn_memxattn_sqrelu"


def rms_norm(x, g, eps=NORM_EPS):
    xf = x.astype(jnp.float32)
    y = xf * lax.rsqrt(jnp.mean(xf * xf, axis=-1, keepdims=True) + eps)
    return (y * g.astype(jnp.float32)).astype(x.dtype)


def rope_tables(positions, dim):
    inv = ROPE_THETA ** (-jnp.arange(0, dim, 2, dtype=jnp.float32) / dim)
    ang = positions.astype(jnp.float32)[..., None] * inv
    ang = jnp.concatenate([ang, ang], axis=-1)
    return jnp.cos(ang), jnp.sin(ang)


def apply_rope(x, cos, sin):
    extra = x.ndim - 3
    shp = cos.shape[:2] + (1,) * extra + cos.shape[-1:]
    cos, sin = cos.reshape(shp), sin.reshape(shp)
    x1, x2 = jnp.split(x, 2, axis=-1)
    rot = jnp.concatenate([-x2, x1], axis=-1)
    return (x * cos + rot * sin).astype(x.dtype)


def ssd_chunked_scan(xs, dt, a, bm, cm):
    Bsz, L, H, P = xs.shape
    G, N = SSD_GROUPS, SSD_STATE
    R = H // G
    nc = L // CHUNK
    f32 = jnp.float32
    xdt = (xs.astype(f32) * dt[..., None]).reshape(Bsz, nc, CHUNK, G, R, P)
    da = (dt * a).reshape(Bsz, nc, CHUNK, G, R)
    bc = bm.astype(f32).reshape(Bsz, nc, CHUNK, G, N)
    cc = cm.astype(f32).reshape(Bsz, nc, CHUNK, G, N)
    cum = jnp.cumsum(da, axis=2)
    causal = jnp.tril(jnp.ones((CHUNK, CHUNK), dtype=bool))
    seg = cum[:, :, :, None] - cum[:, :, None, :]
    decay = jnp.exp(jnp.where(causal[None, None, :, :, None, None], seg, -jnp.inf))
    cb = jnp.einsum('bclgn,bcsgn->bclsg', cc, bc)
    y_diag = jnp.einsum('bclsg,bclsgr,bcsgrp->bclgrp', cb, decay, xdt)
    to_end = jnp.exp(cum[:, :, -1:] - cum)
    chunk_states = jnp.einsum('bclgn,bclgr,bclgrp->bcgrpn', bc, to_end, xdt)
    chunk_decay = jnp.exp(cum[:, :, -1])

    def carry_state(h, inp):
        s_c, d_c = inp
        return h * d_c[..., None, None] + s_c, h

    h0 = jnp.zeros((Bsz, G, R, P, N), f32)
    _, h_in = lax.scan(carry_state, h0,
                       (jnp.moveaxis(chunk_states, 1, 0), jnp.moveaxis(chunk_decay, 1, 0)))
    h_in = jnp.moveaxis(h_in, 0, 1)
    y_off = jnp.einsum('bclgn,bcgrpn,bclgr->bclgrp', cc, h_in, jnp.exp(cum))
    return (y_diag + y_off).reshape(Bsz, L, H, P).astype(xs.dtype)


def ssd_mixer(z, xbc, dt_raw, conv_w, conv_b, dt_bias, a_log, d_skip, norm_w):
    Bsz, L, _ = z.shape
    xbc = lax.conv_general_dilated(
        xbc, conv_w, window_strides=(1,), padding=[(CONV_WIDTH - 1, 0)],
        dimension_numbers=('NWC', 'WIO', 'NWC'), feature_group_count=D_XBC)
    xbc = jax.nn.silu(xbc + conv_b)
    xs, bm, cm = jnp.split(xbc, [D_SSD, D_SSD + SSD_GROUPS * SSD_STATE], axis=-1)
    xs = xs.reshape(Bsz, L, SSD_HEADS, SSD_HEAD_DIM)
    bm = bm.reshape(Bsz, L, SSD_GROUPS, SSD_STATE)
    cm = cm.reshape(Bsz, L, SSD_GROUPS, SSD_STATE)
    dt = jax.nn.softplus((dt_raw + dt_bias).astype(jnp.float32))
    a = -jnp.exp(a_log.astype(jnp.float32))
    y = ssd_chunked_scan(xs, dt, a, bm, cm)
    y = (y + d_skip[:, None] * xs).reshape(Bsz, L, D_SSD)
    return rms_norm(y * jax.nn.silu(z), norm_w)


def diff_attention(q, k, v, cos, sin, lam, subln_w, lambda_init):
    Bsz, L, _ = q.shape
    q = apply_rope(q.reshape(Bsz, L, DIFF_HEADS, 2, DIFF_HEAD_DIM), cos, sin)
    k = apply_rope(k.reshape(Bsz, L, DIFF_HEADS, 2, DIFF_HEAD_DIM), cos, sin)
    q = q.transpose(0, 2, 3, 1, 4)
    k = k.transpose(0, 2, 3, 1, 4)
    v = v.reshape(Bsz, L, DIFF_HEADS, 2 * DIFF_HEAD_DIM).transpose(0, 2, 1, 3)
    scale = DIFF_HEAD_DIM ** -0.5
    key_pos = jnp.arange(L)

    def block(i):
        start = i * Q_BLOCK
        qb = lax.dynamic_slice_in_dim(q, start, Q_BLOCK, axis=3)
        s = jnp.einsum('bhcqd,bhckd->bhcqk', qb, k,
                       preferred_element_type=jnp.float32) * scale
        causal = (start + jnp.arange(Q_BLOCK))[:, None] >= key_pos[None, :]
        s = jnp.where(causal, s, -jnp.inf)
        p = jax.nn.softmax(s, axis=-1)
        attn = p[:, :, 0] - lam * p[:, :, 1]
        return jnp.einsum('bhqk,bhkv->bhqv', attn.astype(v.dtype), v)

    o = lax.map(block, jnp.arange(L // Q_BLOCK))
    o = o.transpose(1, 0, 3, 2, 4).reshape(Bsz, L, DIFF_HEADS, 2 * DIFF_HEAD_DIM)
    o = rms_norm(o, subln_w) * (1.0 - lambda_init)
    return o.reshape(Bsz, L, D_DIFF)


def cross_attention(h, mem_h, wq, wk, wv, wo):
    Bsz, L, _ = h.shape
    M = mem_h.shape[1]
    q = (h @ wq).reshape(Bsz, L, MEM_HEADS, MEM_HEAD_DIM)
    k = (mem_h @ wk).reshape(Bsz, M, MEM_HEADS, MEM_HEAD_DIM)
    v = (mem_h @ wv).reshape(Bsz, M, MEM_HEADS, MEM_HEAD_DIM)
    s = jnp.einsum('bqhd,bkhd->bhqk', q, k,
                   preferred_element_type=jnp.float32) * (MEM_HEAD_DIM ** -0.5)
    p = jax.nn.softmax(s, axis=-1)
    o = jnp.einsum('bhqk,bkhd->bqhd', p.astype(v.dtype), v).reshape(Bsz, L, D_MODEL)
    return o @ wo


def setup_inputs(seed: int = 0) -> dict:
    key = jax.random.key(seed)
    ks = jax.random.split(key, 32)
    f32 = jnp.float32

    def nrm(k, shape, scale):
        return jax.random.normal(k, shape, f32) * scale

    def gain(k, dim):
        return 1.0 + nrm(k, (DEPTH, dim), 0.02)

    x = nrm(ks[0], (BATCH, SEQ, D_MODEL), 1.0)
    mem = nrm(ks[1], (BATCH, MEM_LEN, D_MODEL), 1.0)
    offset = jax.random.randint(ks[2], (BATCH, 1), 0, 1024, dtype=jnp.int32)
    positions = offset + jnp.arange(SEQ, dtype=jnp.int32)[None, :]
    dt0 = jnp.exp(jax.random.uniform(ks[3], (DEPTH, SSD_HEADS), f32,
                                     math.log(1e-3), math.log(1e-1)))
    dt_bias = dt0 + jnp.log(-jnp.expm1(-dt0))
    a_log = jnp.log(jax.random.uniform(ks[4], (DEPTH, SSD_HEADS), f32, 1.0, 16.0))
    return {
        "x": x,
        "mem": mem,
        "positions": positions,
        "norm_mix_pre": gain(ks[5], D_MODEL),
        "norm_mix_post": gain(ks[6], D_MODEL),
        "norm_mem_q": gain(ks[7], D_MODEL),
        "norm_mem_kv": gain(ks[8], D_MODEL),
        "norm_mem_post": gain(ks[9], D_MODEL),
        "norm_mlp_pre": gain(ks[10], D_MODEL),
        "norm_mlp_post": gain(ks[11], D_MODEL),
        "w_in": nrm(ks[12], (DEPTH, D_MODEL, D_IN), D_MODEL ** -0.5),
        "conv_w": nrm(ks[13], (DEPTH, CONV_WIDTH, 1, D_XBC), CONV_WIDTH ** -0.5),
        "conv_b": nrm(ks[14], (DEPTH, D_XBC), 0.02),
        "dt_bias": dt_bias,
        "a_log": a_log,
        "d_skip": 1.0 + nrm(ks[15], (DEPTH, SSD_HEADS), 0.1),
        "ssd_norm_w": gain(ks[16], D_SSD),
        "lambda_q1": nrm(ks[17], (DEPTH, DIFF_HEAD_DIM), 0.1),
        "lambda_k1": nrm(ks[18], (DEPTH, DIFF_HEAD_DIM), 0.1),
        "lambda_q2": nrm(ks[19], (DEPTH, DIFF_HEAD_DIM), 0.1),
        "lambda_k2": nrm(ks[20], (DEPTH, DIFF_HEAD_DIM), 0.1),
        "subln_w": gain(ks[21], 2 * DIFF_HEAD_DIM),
        "w_out": nrm(ks[22], (DEPTH, D_MIX, D_MODEL), D_MIX ** -0.5),
        "w_mq": nrm(ks[23], (DEPTH, D_MODEL, D_MODEL), D_MODEL ** -0.5),
        "w_mk": nrm(ks[24], (DEPTH, D_MODEL, D_MODEL), D_MODEL ** -0.5),
        "w_mv": nrm(ks[25], (DEPTH, D_MODEL, D_MODEL), D_MODEL ** -0.5),
        "w_mo": nrm(ks[26], (DEPTH, D_MODEL, D_MODEL), D_MODEL ** -0.5),
        "w_up": nrm(ks[27], (DEPTH, D_MODEL, D_FF), D_MODEL ** -0.5),
        "w_down": nrm(ks[28], (DEPTH, D_FF, D_MODEL), D_FF ** -0.5),
    }


def reference(x, mem, positions, norm_mix_pre, norm_mix_post, norm_mem_q, norm_mem_kv,
              norm_mem_post, norm_mlp_pre, norm_mlp_post, w_in, conv_w, conv_b, dt_bias,
              a_log, d_skip, ssd_norm_w, lambda_q1, lambda_k1, lambda_q2, lambda_k2,
              subln_w, w_out, w_mq, w_mk, w_mv, w_mo, w_up, w_down):
    cos, sin = rope_tables(positions, DIFF_HEAD_DIM)
    split_at = [D_SSD, D_SSD + D_XBC, D_SSD + D_XBC + SSD_HEADS,
                D_SSD + D_XBC + SSD_HEADS + D_DIFF,
                D_SSD + D_XBC + SSD_HEADS + 2 * D_DIFF]
    for l in range(DEPTH):
        lambda_init = 0.8 - 0.6 * math.exp(-0.3 * l)
        h = rms_norm(x, norm_mix_pre[l])
        z, xbc, dt_raw, q, k, v = jnp.split(h @ w_in[l], split_at, axis=-1)
        y_ssd = ssd_mixer(z, xbc, dt_raw, conv_w[l], conv_b[l], dt_bias[l], a_log[l],
                          d_skip[l], ssd_norm_w[l])
        lam = (jnp.exp(jnp.sum(lambda_q1[l].astype(jnp.float32) * lambda_k1[l]))
               - jnp.exp(jnp.sum(lambda_q2[l].astype(jnp.float32) * lambda_k2[l]))
               + lambda_init)
        y_diff = diff_attention(q, k, v, cos, sin, lam, subln_w[l], lambda_init)
        mixed = jnp.concatenate([y_ssd, y_diff], axis=-1) @ w_out[l]
        x = x + rms_norm(mixed, norm_mix_post[l])
        h = rms_norm(x, norm_mem_q[l])
        mem_h = rms_norm(mem, norm_mem_kv[l])
        c = cross_attention(h, mem_h, w_mq[l], w_mk[l], w_mv[l], w_mo[l])
        x = x + rms_norm(c, norm_mem_post[l])
        h = rms_norm(x, norm_mlp_pre[l])
        m = jnp.square(jax.nn.relu(h @ w_up[l])) @ w_down[l]
        x = x + rms_norm(m, norm_mlp_post[l])
    return x
```

```cpp
#include <hip/hip_runtime.h>
#include <hip/hip_cooperative_groups.h>
#include <cstdio>
#include <cstdint>
namespace cg = cooperative_groups;

#ifndef MK_SINGLE
#define MK_SINGLE 1
#endif

constexpr int BATCH = 8, SEQ = 2048, DM = 1024, M = BATCH * SEQ, MEM_LEN = 256, MM = BATCH * MEM_LEN;
constexpr int D_SSD = 512, SSD_HD = 64, SSD_H = 8, SSD_N = 128, CHUNK = 128, NCH = SEQ / CHUNK;
constexpr int D_IN = 3080, NP = 3072;
constexpr int CZ = 0, CXBC = 512, CQ = 1536, CK = 2048, CV = 2560;
constexpr int DH = 4;
constexpr int MH = 4, MHD = 256, DFF = 4096;
constexpr float EPS = 1e-6f;
constexpr float LOG2E = 1.4426950408889634f;
constexpr float C2_DIFF = 0.125f * LOG2E;
constexpr float C2_MEM = 0.0625f * LOG2E;
constexpr float LAMBDA_INIT = 0.2f;

constexpr size_t MiB = 1u << 20;
constexpr size_t WS_WIN = 2 * MiB, WS_WOUT = 8 * MiB, WS_WMQ = 10 * MiB, WS_WMKV = 12 * MiB, WS_WMO = 16 * MiB, WS_WUP = 18 * MiB, WS_WDN = 26 * MiB;
constexpr size_t WS_DT = 37 * MiB, WS_SSQ = 37 * MiB + 512 * 1024, WS_COS = 38 * MiB, WS_SIN = 40 * MiB;
constexpr size_t WS_MEMH = 42 * MiB, WS_KVM = 46 * MiB, WS_ST = 54 * MiB, WS_DEC = 86 * MiB, WS_XN = 88 * MiB;
constexpr size_t WS_ZX = 128 * MiB, WS_Y = 224 * MiB, WS_T = 128 * MiB, WS_QM = 192 * MiB, WS_OM = 224 * MiB, WS_H = 128 * MiB, WS_T2 = 56 * MiB;
constexpr size_t WS_END = 256 * MiB;

constexpr int LDS_BYTES = 147456;
constexpr int NTHREADS = 512;

typedef unsigned short bf16_t;
typedef short bf16x8 __attribute__((ext_vector_type(8)));
typedef float f32x4 __attribute__((ext_vector_type(4)));

__device__ __forceinline__ float bf2f(bf16_t v) { return __uint_as_float(((unsigned)v) << 16); }
__device__ __forceinline__ bf16_t f2bf(float f) { unsigned u = __float_as_uint(f); return (bf16_t)((u + 0x7fffu + ((u >> 16) & 1u)) >> 16); }
__device__ __forceinline__ unsigned pk2(float lo, float hi) { return (unsigned)f2bf(lo) | ((unsigned)f2bf(hi) << 16); }
__device__ __forceinline__ float wave_sum(float v) {
#pragma unroll
    for (int o = 1; o < 64; o <<= 1) v += __shfl_xor(v, o);
    return v;
}
__device__ __forceinline__ float silu_f(float x) { return x / (1.f + expf(-x)); }
__device__ __forceinline__ float softplus_f(float x) { return x > 20.f ? x : log1pf(expf(x)); }

struct Args {
    const float* in[29];
    float* out;
    unsigned char* ws;
    int ph_lo, ph_hi, coop, pad;
};

struct Frame {
    unsigned char* lds;
    int tid, lane, wave, gw, ngw;
    const Args* a;
};

__device__ __forceinline__ void transpose_item(const float* W, int ldw, int src_col0, int K, bf16_t* WT, int n0, int k0, float* scr, int lane) {
#pragma unroll 8
    for (int i = 0; i < 32; ++i) { const int kk = 2 * i + (lane >> 5); scr[kk * 33 + (lane & 31)] = W[(size_t)(k0 + kk) * ldw + src_col0 + n0 + (lane & 31)]; }
    __builtin_amdgcn_wave_barrier();
    asm volatile("s_waitcnt lgkmcnt(0)" ::: "memory");
    const int c = lane & 7;
#pragma unroll
    for (int j = 0; j < 4; ++j) { const int n = (lane >> 3) + 8 * j; const float* s = scr + (8 * c) * 33 + n;
        uint4 o; o.x = pk2(s[0 * 33], s[1 * 33]); o.y = pk2(s[2 * 33], s[3 * 33]); o.z = pk2(s[4 * 33], s[5 * 33]); o.w = pk2(s[6 * 33], s[7 * 33]);
        *(uint4*)(WT + (size_t)(n0 + n) * K + k0 + 8 * c) = o; }
    asm volatile("s_waitcnt lgkmcnt(0)" ::: "memory");
    __builtin_amdgcn_wave_barrier();
}

__device__ __forceinline__ void rms_row(const float* xrow, const float* g, bf16_t* orow, int lane, f32x4 (&v)[4]) {
    const f32x4* xr = (const f32x4*)xrow + lane; const f32x4* gr = (const f32x4*)g + lane;
    float s = 0.f;
#pragma unroll
    for (int j = 0; j < 4; ++j) { v[j] = xr[64 * j]; s += (v[j].x * v[j].x + v[j].y * v[j].y) + (v[j].z * v[j].z + v[j].w * v[j].w); }
    const float r = 1.0f / sqrtf(wave_sum(s) * (1.f / DM) + EPS);
#pragma unroll
    for (int j = 0; j < 4; ++j) { const f32x4 gg = gr[64 * j]; v[j] = v[j] * r * gg;
        uint2 o; o.x = pk2(v[j].x, v[j].y); o.y = pk2(v[j].z, v[j].w); *((uint2*)orow + lane + 64 * j) = o; }
}

__device__ __forceinline__ void phase_prologue(Frame& F) {
    const Args& A = *F.a; unsigned char* ws = A.ws;
    float* scr = (float*)(F.lds + F.wave * 8704);
    float* dtw = (float*)(F.lds + 73728);
    for (int e = F.tid; e < 1024 * 8; e += NTHREADS) dtw[e] = A.in[10][(size_t)(e >> 3) * D_IN + 1536 + (e & 7)];
    constexpr int I_IN = 16 * 96, I_SQ = 16 * 32, I_UP = 16 * 128, I_DN = 64 * 32;
    constexpr int NITEMS = I_IN + 5 * I_SQ + I_UP + I_DN;
    for (int it = F.gw; it < NITEMS; it += F.ngw) {
        int r = it;
        if (r < I_IN) { const int nb = r % 96, kb = r / 96; const int n0 = nb * 32; transpose_item(A.in[10], D_IN, n0 >= 1536 ? 8 : 0, 1024, (bf16_t*)(ws + WS_WIN), n0, kb * 64, scr, F.lane); continue; } r -= I_IN;
        if (r < I_SQ) { transpose_item(A.in[22], 1024, 0, 1024, (bf16_t*)(ws + WS_WOUT), (r % 32) * 32, (r / 32) * 64, scr, F.lane); continue; } r -= I_SQ;
        if (r < I_SQ) { transpose_item(A.in[23], 1024, 0, 1024, (bf16_t*)(ws + WS_WMQ), (r % 32) * 32, (r / 32) * 64, scr, F.lane); continue; } r -= I_SQ;
        if (r < I_SQ) { transpose_item(A.in[24], 1024, 0, 1024, (bf16_t*)(ws + WS_WMKV), (r % 32) * 32, (r / 32) * 64, scr, F.lane); continue; } r -= I_SQ;
        if (r < I_SQ) { transpose_item(A.in[25], 1024, 0, 1024, (bf16_t*)(ws + WS_WMKV) + (size_t)1024 * 1024, (r % 32) * 32, (r / 32) * 64, scr, F.lane); continue; } r -= I_SQ;
        if (r < I_SQ) { transpose_item(A.in[26], 1024, 0, 1024, (bf16_t*)(ws + WS_WMO), (r % 32) * 32, (r / 32) * 64, scr, F.lane); continue; } r -= I_SQ;
        if (r < I_UP) { transpose_item(A.in[27], 4096, 0, 1024, (bf16_t*)(ws + WS_WUP), (r % 128) * 32, (r / 128) * 64, scr, F.lane); continue; } r -= I_UP;
        transpose_item(A.in[28], 1024, 0, 4096, (bf16_t*)(ws + WS_WDN), (r % 32) * 32, (r / 32) * 64, scr, F.lane);
    }
    __syncthreads();
    for (int m = F.gw; m < M; m += F.ngw) {
        f32x4 v[4];
        rms_row(A.in[0] + (size_t)m * DM, A.in[3], (bf16_t*)(ws + WS_XN) + (size_t)m * DM, F.lane, v);
        float acc[8];
#pragma unroll
        for (int h = 0; h < 8; ++h) acc[h] = 0.f;
#pragma unroll 1
        for (int j = 0; j < 4; ++j)
#pragma unroll
            for (int e = 0; e < 4; ++e) { const int k = 256 * j + 4 * F.lane + e; const f32x4 w0 = *(const f32x4*)(dtw + k * 8), w1 = *(const f32x4*)(dtw + k * 8 + 4); const float hv = v[j][e];
                acc[0] += hv * w0.x; acc[1] += hv * w0.y; acc[2] += hv * w0.z; acc[3] += hv * w0.w; acc[4] += hv * w1.x; acc[5] += hv * w1.y; acc[6] += hv * w1.z; acc[7] += hv * w1.w; }
#pragma unroll
        for (int h = 0; h < 8; ++h) acc[h] = wave_sum(acc[h]);
        if (F.lane == 0) { float* d = (float*)(ws + WS_DT) + (size_t)m * 8;
#pragma unroll
            for (int h = 0; h < 8; ++h) d[h] = acc[h]; }
    }
    for (int m = F.gw; m < MM; m += F.ngw) { f32x4 v[4]; rms_row(A.in[1] + (size_t)m * DM, A.in[6], (bf16_t*)(ws + WS_MEMH) + (size_t)m * DM, F.lane, v); }
    { const int gt = blockIdx.x * NTHREADS + F.tid, ngt = gridDim.x * NTHREADS; const int* pos = (const int*)A.in[2];
      float* C = (float*)(ws + WS_COS); float* S = (float*)(ws + WS_SIN);
      for (int e = gt; e < M * 32; e += ngt) { const int t = e >> 5, i = e & 31; const float inv = powf(10000.f, -(float)i / 32.f); const float ang = (float)pos[t] * inv; float sn, cs; sincosf(ang, &sn, &cs); C[e] = cs; S[e] = sn; } }
}

struct EpiBf16 { bf16_t* O; int ldc; float scale;
    __device__ __forceinline__ void operator()(int row, int col, f32x4 v) const { uint2 o; o.x = pk2(v.x * scale, v.y * scale); o.y = pk2(v.z * scale, v.w * scale); *(uint2*)(O + (size_t)row * ldc + col) = o; } };
struct EpiF32 { float* O; int ldc;
    __device__ __forceinline__ void operator()(int row, int col, f32x4 v) const { *(f32x4*)(O + (size_t)row * ldc + col) = v; } };
struct EpiRelu2 { bf16_t* O; int ldc;
    __device__ __forceinline__ void operator()(int row, int col, f32x4 v) const { float a = fmaxf(v.x, 0.f), b = fmaxf(v.y, 0.f), c = fmaxf(v.z, 0.f), d = fmaxf(v.w, 0.f);
        uint2 o; o.x = pk2(a * a, b * b); o.y = pk2(c * c, d * d); *(uint2*)(O + (size_t)row * ldc + col) = o; } };

template <class Epi>
__device__ __forceinline__ void gemm_simple(Frame& F, const bf16_t* A, int lda, const bf16_t* Bt, int ldb, int Mr, int Nc, int K, const Epi& E) {
    bf16_t* As = (bf16_t*)F.lds; bf16_t* Bs = As + 128 * 40;
    const int tid = F.tid, lane = F.lane, wid = F.wave, wr = wid >> 2, wc = wid & 3, fr = lane & 15, fq = lane >> 4;
    const int ntn = Nc / 128, ntiles = (Mr / 128) * ntn;
    for (int u = blockIdx.x; u < ntiles; u += gridDim.x) {
        const int tm = u / ntn, tn = u % ntn;
        f32x4 acc[4][2];
#pragma unroll
        for (int m = 0; m < 4; ++m)
#pragma unroll
            for (int n = 0; n < 2; ++n) acc[m][n] = (f32x4){0.f, 0.f, 0.f, 0.f};
        const bf16_t* Ag = A + (size_t)(tm * 128 + (tid >> 2)) * lda + (tid & 3) * 8;
        const bf16_t* Bg = Bt + (size_t)(tn * 128 + (tid >> 2)) * ldb + (tid & 3) * 8;
        for (int k0 = 0; k0 < K; k0 += 32) {
            const uint4 va = *(const uint4*)(Ag + k0), vb = *(const uint4*)(Bg + k0);
            __syncthreads();
            *(uint4*)(As + (tid >> 2) * 40 + (tid & 3) * 8) = va;
            *(uint4*)(Bs + (tid >> 2) * 40 + (tid & 3) * 8) = vb;
            __syncthreads();
            bf16x8 af[4], bfr[2];
#pragma unroll
            for (int m = 0; m < 4; ++m) af[m] = *(const bf16x8*)(As + (wr * 64 + m * 16 + fr) * 40 + fq * 8);
#pragma unroll
            for (int n = 0; n < 2; ++n) bfr[n] = *(const bf16x8*)(Bs + (wc * 32 + n * 16 + fr) * 40 + fq * 8);
#pragma unroll
            for (int m = 0; m < 4; ++m)
#pragma unroll
                for (int n = 0; n < 2; ++n) acc[m][n] = __builtin_amdgcn_mfma_f32_16x16x32_bf16(bfr[n], af[m], acc[m][n], 0, 0, 0);
        }
#pragma unroll
        for (int m = 0; m < 4; ++m)
#pragma unroll
            for (int n = 0; n < 2; ++n) E(tm * 128 + wr * 64 + m * 16 + fr, tn * 128 + wc * 32 + n * 16 + fq * 4, acc[m][n]);
    }
    __syncthreads();
}

__device__ __forceinline__ void phase_rope(Frame& F) {
    unsigned char* ws = F.a->ws; bf16_t* ZX = (bf16_t*)(ws + WS_ZX); const float* C = (const float*)(ws + WS_COS); const float* S = (const float*)(ws + WS_SIN);
    for (int t = F.gw; t < M; t += F.ngw) {
        bf16_t* row = ZX + (size_t)t * NP;
#pragma unroll
        for (int j = 0; j < 8; ++j) { const int idx = F.lane + 64 * j; const int tensor = idx >> 8, grp = (idx >> 5) & 7, i = idx & 31;
            const int cl = (tensor ? CK : CQ) + grp * 64 + i; const float cs = C[t * 32 + i], sn = S[t * 32 + i];
            const float x1 = bf2f(row[cl]), x2 = bf2f(row[cl + 32]); const float sc = tensor ? 1.f : C2_DIFF;
            row[cl] = f2bf((x1 * cs - x2 * sn) * sc); row[cl + 32] = f2bf((x2 * cs + x1 * sn) * sc); }
    }
}

template <class Fn>
__device__ __forceinline__ void ssd_conv(Frame& F, int b, int c, int xc0, int ncols, const Fn& fn) {
    const bf16_t* ZX = (const bf16_t*)(F.a->ws + WS_ZX); const float* cw = F.a->in[11]; const float* cb = F.a->in[12];
    for (int e = F.tid; e < 128 * ncols; e += NTHREADS) { const int l = e / ncols, j = e % ncols, xc = xc0 + j; const int s = c * CHUNK + l;
        float acc = cb[xc];
#pragma unroll
        for (int w = 0; w < 4; ++w) { const int ss = s - 3 + w; if (ss >= 0) acc += cw[w * 1024 + xc] * bf2f(ZX[(size_t)(b * SEQ + ss) * NP + CXBC + xc]); }
        fn(l, j, silu_f(acc)); }
}
__device__ __forceinline__ void ssd_dt_cum(Frame& F, int b, int c, int h, float* dtl, float* cuml) {
    const float* DT = (const float*)(F.a->ws + WS_DT);
    if (F.tid < 128) { const float dt = softplus_f(DT[(size_t)(b * SEQ + c * CHUNK + F.tid) * 8 + h] + F.a->in[13][h]); const float a = -expf(F.a->in[14][h]); dtl[F.tid] = dt; cuml[F.tid] = dt * a; }
    __syncthreads();
    if (F.tid == 0) { float s = 0.f; for (int l = 0; l < 128; ++l) { s += cuml[l]; cuml[l] = s; } }
    __syncthreads();
}
__device__ __forceinline__ void phase_ssd_states(Frame& F) {
    float* xw = (float*)F.lds; float* Bm = (float*)(F.lds + 32768); float* dtl = (float*)(F.lds + 98304); float* cuml = dtl + 128;
    float* ST = (float*)(F.a->ws + WS_ST); float* DEC = (float*)(F.a->ws + WS_DEC);
    for (int u = blockIdx.x; u < BATCH * NCH * SSD_H; u += gridDim.x) {
        const int h = u & 7, c = (u >> 3) & 15, b = u >> 7, g = h >> 2;
        ssd_dt_cum(F, b, c, h, dtl, cuml);
        const float clast = cuml[127];
        ssd_conv(F, b, c, h * 64, 64, [&](int l, int j, float v) { xw[l * 64 + j] = v * dtl[l] * expf(clast - cuml[l]); });
        ssd_conv(F, b, c, 512 + g * 128, 128, [&](int l, int j, float v) { Bm[l * 128 + j] = bf2f(f2bf(v)); });
        __syncthreads();
        const int p = F.tid >> 3, n0 = (F.tid & 7) * 16;
        float acc[16];
#pragma unroll
        for (int i = 0; i < 16; ++i) acc[i] = 0.f;
        for (int l = 0; l < 128; ++l) { const float xv = xw[l * 64 + p];
#pragma unroll
            for (int i = 0; i < 16; ++i) acc[i] += xv * Bm[l * 128 + n0 + i]; }
        float* dst = ST + ((size_t)u * 64 + p) * 128 + n0;
#pragma unroll
        for (int i = 0; i < 16; i += 4) *(f32x4*)(dst + i) = (f32x4){acc[i], acc[i + 1], acc[i + 2], acc[i + 3]};
        if (F.tid == 0) DEC[u] = expf(clast);
        __syncthreads();
    }
}
__device__ __forceinline__ void phase_ssd_y(Frame& F) {
    bf16_t* Cb = (bf16_t*)F.lds; bf16_t* Bb = (bf16_t*)(F.lds + 32768); float* Hin = (float*)(F.lds + 32768); bf16_t* Mb = (bf16_t*)(F.lds + 65536);
    float* xs = (float*)(F.lds + 98304); float* dtl = (float*)(F.lds + 131072); float* cuml = dtl + 128;
    const float* ST = (const float*)(F.a->ws + WS_ST); const float* DEC = (const float*)(F.a->ws + WS_DEC);
    const bf16_t* ZX = (const bf16_t*)(F.a->ws + WS_ZX); bf16_t* Y = (bf16_t*)(F.a->ws + WS_Y); float* SSQ = (float*)(F.a->ws + WS_SSQ);
    for (int u = blockIdx.x; u < BATCH * NCH * SSD_H; u += gridDim.x) {
        const int h = u & 7, c = (u >> 3) & 15, b = u >> 7, g = h >> 2;
        ssd_dt_cum(F, b, c, h, dtl, cuml);
        ssd_conv(F, b, c, h * 64, 64, [&](int l, int j, float v) { xs[l * 64 + j] = bf2f(f2bf(v)); });
        ssd_conv(F, b, c, 512 + g * 128, 128, [&](int l, int j, float v) { Bb[l * 128 + j] = f2bf(v); });
        ssd_conv(F, b, c, 768 + g * 128, 128, [&](int l, int j, float v) { Cb[l * 128 + j] = f2bf(v); });
        __syncthreads();
        {
            const int l = F.tid >> 2; const float cl = cuml[l];
#pragma unroll 1
            for (int half = 0; half < 2; ++half) {
                const int s0 = (F.tid & 3) * 32 + half * 16;
                float acc[16];
#pragma unroll
                for (int i = 0; i < 16; ++i) acc[i] = 0.f;
#pragma unroll 1
                for (int nb = 0; nb < 16; ++nb) {
                    const bf16x8 c8 = *(const bf16x8*)(Cb + l * 128 + nb * 8); float cf[8];
#pragma unroll
                    for (int q = 0; q < 8; ++q) cf[q] = bf2f((bf16_t)c8[q]);
#pragma unroll
                    for (int i = 0; i < 16; ++i) { const bf16x8 b8 = *(const bf16x8*)(Bb + (s0 + i) * 128 + nb * 8);
#pragma unroll
                        for (int q = 0; q < 8; ++q) acc[i] += cf[q] * bf2f((bf16_t)b8[q]); }
                }
#pragma unroll
                for (int i = 0; i < 16; ++i) { const int s = s0 + i; Mb[l * 128 + s] = f2bf(s <= l ? acc[i] * expf(cl - cuml[s]) * dtl[s] : 0.f); }
            }
        }
        __syncthreads();
        {
            const int p = F.tid >> 3, n0 = (F.tid & 7) * 16;
            float hc[16];
#pragma unroll
            for (int i = 0; i < 16; ++i) hc[i] = 0.f;
            for (int j = 0; j < c; ++j) { const int uj = (b * NCH + j) * 8 + h; const float d = DEC[uj]; const float* src = ST + ((size_t)uj * 64 + p) * 128 + n0;
#pragma unroll
                for (int i = 0; i < 16; i += 4) { const f32x4 sv = *(const f32x4*)(src + i); hc[i] = hc[i] * d + sv.x; hc[i + 1] = hc[i + 1] * d + sv.y; hc[i + 2] = hc[i + 2] * d + sv.z; hc[i + 3] = hc[i + 3] * d + sv.w; } }
#pragma unroll
            for (int i = 0; i < 16; ++i) Hin[(n0 + i) * 64 + p] = hc[i];
        }
        __syncthreads();
        {
            const int l = F.tid >> 2, p0 = (F.tid & 3) * 16;
            float yd[16], yo[16];
#pragma unroll
            for (int i = 0; i < 16; ++i) { yd[i] = 0.f; yo[i] = 0.f; }
            for (int s = 0; s <= l; ++s) { const float mv = bf2f(Mb[l * 128 + s]);
#pragma unroll
                for (int i = 0; i < 16; ++i) yd[i] += mv * xs[s * 64 + p0 + i]; }
            for (int n = 0; n < 128; ++n) { const float cv = bf2f(Cb[l * 128 + n]);
#pragma unroll
                for (int i = 0; i < 16; ++i) yo[i] += cv * Hin[n * 64 + p0 + i]; }
            const float ec = expf(cuml[l]), dsk = F.a->in[15][h]; const size_t t = (size_t)(b * SEQ + c * CHUNK + l);
            float ssq = 0.f; float vv[16];
#pragma unroll
            for (int i = 0; i < 16; ++i) { const float y = yd[i] + ec * yo[i] + dsk * xs[l * 64 + p0 + i]; const float z = bf2f(ZX[t * NP + CZ + h * 64 + p0 + i]); const float v = y * silu_f(z); vv[i] = v; ssq += v * v; }
            ssq += __shfl_xor(ssq, 1); ssq += __shfl_xor(ssq, 2);
            bf16_t* yo_p = Y + t * DM + h * 64 + p0;
#pragma unroll
            for (int i = 0; i < 16; i += 4) { uint2 o; o.x = pk2(vv[i], vv[i + 1]); o.y = pk2(vv[i + 2], vv[i + 3]); *(uint2*)(yo_p + i) = o; }
            if ((F.tid & 3) == 0) SSQ[t * 8 + h] = ssq;
        }
        __syncthreads();
    }
}
__device__ __forceinline__ void phase_ssd_norm(Frame& F) {
    bf16_t* Y = (bf16_t*)(F.a->ws + WS_Y); const float* SSQ = (const float*)(F.a->ws + WS_SSQ); const float* w = F.a->in[16];
    for (int t = F.gw; t < M; t += F.ngw) {
        float s = 0.f;
#pragma unroll
        for (int h = 0; h < 8; ++h) s += SSQ[(size_t)t * 8 + h];
        const float r = 1.0f / sqrtf(s * (1.f / D_SSD) + EPS);
        bf16_t* row = Y + (size_t)t * DM;
#pragma unroll
        for (int j = 0; j < 2; ++j) { const int col = (F.lane + 64 * j) * 4; uint2 o = *(uint2*)(row + col); const f32x4 wv = *(const f32x4*)(w + col);
            const float a0 = bf2f((bf16_t)(o.x & 0xffff)) * r * wv.x, a1 = bf2f((bf16_t)(o.x >> 16)) * r * wv.y, a2 = bf2f((bf16_t)(o.y & 0xffff)) * r * wv.z, a3 = bf2f((bf16_t)(o.y >> 16)) * r * wv.w;
            o.x = pk2(a0, a1); o.y = pk2(a2, a3); *(uint2*)(row + col) = o; }
    }
}

__device__ __forceinline__ void phase_diff_attn(Frame& F) {
    float* Ks = (float*)F.lds; float* Vs = (float*)(F.lds + 32768); float* Ot = (float*)(F.lds + 65536);
    const bf16_t* ZX = (const bf16_t*)(F.a->ws + WS_ZX); bf16_t* Y = (bf16_t*)(F.a->ws + WS_Y);
    const int pair = F.tid >> 2, row = pair & 63, comp = pair >> 6, sub = F.tid & 3;
    const int NU = BATCH * DH * (SEQ / 64);
    for (int uu = blockIdx.x; uu < NU; uu += gridDim.x) {
        const int qblk = 31 - (uu / (BATCH * DH)), bh = uu % (BATCH * DH), b = bh / DH, h = bh % DH;
        const int qidx = qblk * 64 + row; const size_t tq = (size_t)b * SEQ + qidx;
        float q[16];
#pragma unroll
        for (int i = 0; i < 16; ++i) q[i] = bf2f(ZX[tq * NP + CQ + h * 128 + comp * 64 + sub * 16 + i]);
        float o[32];
#pragma unroll
        for (int i = 0; i < 32; ++i) o[i] = 0.f;
        float mrun = -INFINITY, lrun = 0.f;
        for (int kt = 0; kt <= qblk; ++kt) {
            __syncthreads();
            for (int e = F.tid; e < 8192; e += NTHREADS) { const int cp = e >> 12, j = (e >> 6) & 63, d = e & 63; Ks[e] = bf2f(ZX[((size_t)b * SEQ + kt * 64 + j) * NP + CK + h * 128 + cp * 64 + d]); }
            for (int e = F.tid; e < 8192; e += NTHREADS) { const int j = e >> 7, d = e & 127; Vs[e] = bf2f(ZX[((size_t)b * SEQ + kt * 64 + j) * NP + CV + h * 128 + d]); }
            __syncthreads();
            _Pragma("unroll 1") for (int jb = 0; jb < 8; ++jb) {
                float s[8];
#pragma unroll
                for (int jj = 0; jj < 8; ++jj) { const float* kr = Ks + comp * 4096 + (jb * 8 + jj) * 64 + sub * 16; float a = 0.f;
#pragma unroll
                    for (int i = 0; i < 16; ++i) a += q[i] * kr[i];
                    a += __shfl_xor(a, 1); a += __shfl_xor(a, 2);
                    const int kidx = kt * 64 + jb * 8 + jj; s[jj] = (kidx > qidx) ? -INFINITY : a; }
                float mx = s[0];
#pragma unroll
                for (int jj = 1; jj < 8; ++jj) mx = fmaxf(mx, s[jj]);
                const float mnew = fmaxf(mrun, mx);
                if (mnew > -INFINITY) {
                    const float alpha = exp2f(mrun - mnew); lrun *= alpha;
#pragma unroll
                    for (int i = 0; i < 32; ++i) o[i] *= alpha;
#pragma unroll
                    for (int jj = 0; jj < 8; ++jj) { const float p = exp2f(s[jj] - mnew); lrun += p; const float* vr = Vs + (jb * 8 + jj) * 128 + sub * 32;
#pragma unroll
                        for (int i = 0; i < 32; ++i) o[i] += p * vr[i]; }
                    mrun = mnew;
                }
            }
        }
        const float il = 1.f / lrun;
        __syncthreads();
        if (comp == 1) {
#pragma unroll
            for (int i = 0; i < 32; ++i) Ot[row * 128 + sub * 32 + i] = o[i] * il; }
        __syncthreads();
        if (comp == 0) {
            float a1 = 0.f, a2 = 0.f;
            for (int i = 0; i < 64; ++i) { a1 += F.a->in[17][i] * F.a->in[18][i]; a2 += F.a->in[19][i] * F.a->in[20][i]; }
            const float lam = expf(a1) - expf(a2) + LAMBDA_INIT;
            float ss = 0.f;
#pragma unroll
            for (int i = 0; i < 32; ++i) { o[i] = o[i] * il - lam * Ot[row * 128 + sub * 32 + i]; ss += o[i] * o[i]; }
            ss += __shfl_xor(ss, 1); ss += __shfl_xor(ss, 2);
            const float r = (1.0f / sqrtf(ss * (1.f / 128.f) + EPS)) * (1.f - LAMBDA_INIT);
            bf16_t* dst = Y + tq * DM + 512 + h * 128 + sub * 32; const float* sw = F.a->in[21] + sub * 32;
#pragma unroll
            for (int i = 0; i < 32; i += 2) *(unsigned*)(dst + i) = pk2(o[i] * r * sw[i], o[i + 1] * r * sw[i + 1]);
        }
    }
    __syncthreads();
}

__device__ __forceinline__ void phase_cross_attn(Frame& F) {
    float* Ks = (float*)F.lds; float* Vs = (float*)(F.lds + 32768);
    const bf16_t* QM = (const bf16_t*)(F.a->ws + WS_QM); const bf16_t* KVM = (const bf16_t*)(F.a->ws + WS_KVM); bf16_t* OM = (bf16_t*)(F.a->ws + WS_OM);
    const int row = F.tid >> 3, sub = F.tid & 7;
    const int NU = BATCH * MH * (SEQ / 64);
    for (int uu = blockIdx.x; uu < NU; uu += gridDim.x) {
        const int qblk = uu & 31, hd = (uu >> 5) & 3, b = uu >> 7; const size_t tq = (size_t)b * SEQ + qblk * 64 + row;
        float q[32], o[32];
#pragma unroll
        for (int i = 0; i < 32; ++i) { q[i] = bf2f(QM[tq * DM + hd * 256 + sub * 32 + i]); o[i] = 0.f; }
        float mrun = -INFINITY, lrun = 0.f;
        for (int kt = 0; kt < 8; ++kt) {
            __syncthreads();
            for (int e = F.tid; e < 8192; e += NTHREADS) { const int j = e >> 8, d = e & 255; const size_t r = ((size_t)b * MEM_LEN + kt * 32 + j) * 2048;
                Ks[e] = bf2f(KVM[r + hd * 256 + d]); Vs[e] = bf2f(KVM[r + 1024 + hd * 256 + d]); }
            __syncthreads();
            _Pragma("unroll 1") for (int jb = 0; jb < 4; ++jb) {
                float s[8];
#pragma unroll
                for (int jj = 0; jj < 8; ++jj) { const float* kr = Ks + (jb * 8 + jj) * 256 + sub * 32; float a = 0.f;
#pragma unroll
                    for (int i = 0; i < 32; ++i) a += q[i] * kr[i];
                    a += __shfl_xor(a, 1); a += __shfl_xor(a, 2); a += __shfl_xor(a, 4); s[jj] = a; }
                float mx = s[0];
#pragma unroll
                for (int jj = 1; jj < 8; ++jj) mx = fmaxf(mx, s[jj]);
                const float mnew = fmaxf(mrun, mx); const float alpha = exp2f(mrun - mnew); lrun *= alpha;
#pragma unroll
                for (int i = 0; i < 32; ++i) o[i] *= alpha;
#pragma unroll
                for (int jj = 0; jj < 8; ++jj) { const float p = exp2f(s[jj] - mnew); lrun += p; const float* vr = Vs + (jb * 8 + jj) * 256 + sub * 32;
#pragma unroll
                    for (int i = 0; i < 32; ++i) o[i] += p * vr[i]; }
                mrun = mnew;
            }
        }
        const float il = 1.f / lrun; bf16_t* dst = OM + tq * DM + hd * 256 + sub * 32;
#pragma unroll
        for (int i = 0; i < 32; i += 2) *(unsigned*)(dst + i) = pk2(o[i] * il, o[i + 1] * il);
    }
    __syncthreads();
}

__device__ __forceinline__ void phase_resid_norm(Frame& F, const float* T, const float* base, const float* g_post, float* xo, const float* g_next, bf16_t* XN) {
    for (int m = F.gw; m < M; m += F.ngw) {
        const f32x4* tr = (const f32x4*)(T + (size_t)m * DM) + F.lane; const f32x4* br = (const f32x4*)(base + (size_t)m * DM) + F.lane;
        f32x4 v[4]; float s = 0.f;
#pragma unroll
        for (int j = 0; j < 4; ++j) { v[j] = tr[64 * j]; s += (v[j].x * v[j].x + v[j].y * v[j].y) + (v[j].z * v[j].z + v[j].w * v[j].w); }
        const float r = 1.0f / sqrtf(wave_sum(s) * (1.f / DM) + EPS); float s2 = 0.f;
#pragma unroll
        for (int j = 0; j < 4; ++j) { const f32x4 g = *((const f32x4*)g_post + F.lane + 64 * j); v[j] = br[64 * j] + v[j] * r * g; *((f32x4*)(xo + (size_t)m * DM) + F.lane + 64 * j) = v[j];
            s2 += (v[j].x * v[j].x + v[j].y * v[j].y) + (v[j].z * v[j].z + v[j].w * v[j].w); }
        if (XN) { const float r2 = 1.0f / sqrtf(wave_sum(s2) * (1.f / DM) + EPS);
#pragma unroll
            for (int j = 0; j < 4; ++j) { const f32x4 g = *((const f32x4*)g_next + F.lane + 64 * j); const f32x4 w = v[j] * r2 * g; uint2 o; o.x = pk2(w.x, w.y); o.y = pk2(w.z, w.w); *((uint2*)(XN + (size_t)m * DM) + F.lane + 64 * j) = o; } }
    }
}

constexpr int NPHASE = 16;
__global__ void __launch_bounds__(NTHREADS, 2) mk_fwd(Args args) {
    extern __shared__ __attribute__((aligned(16))) unsigned char lds[];
    Frame F; F.lds = lds; F.tid = threadIdx.x; F.lane = F.tid & 63; F.wave = F.tid >> 6; F.gw = blockIdx.x * 8 + F.wave; F.ngw = gridDim.x * 8; F.a = &args;
    unsigned char* ws = args.ws;
    bf16_t* XN = (bf16_t*)(ws + WS_XN);
    const int lo = args.ph_lo, hi = args.ph_hi;
#ifdef ONLY
#define IN(k) ((k) == ONLY && lo <= (k) && (k) < hi)
#elif defined(PMASK)
#define IN(k) (((PMASK >> (k)) & 1) && lo <= (k) && (k) < hi)
#else
#define IN(k) (lo <= (k) && (k) < hi)
#endif
#if MK_SINGLE
#define SEAM(k) do { if ((k) + 1 < hi) cg::this_grid().sync(); } while (0)
#else
#define SEAM(k) do { } while (0)
#endif
    if (IN(0)) { phase_prologue(F); SEAM(0); }
    if (IN(1)) { gemm_simple(F, XN, DM, (const bf16_t*)(ws + WS_WIN), DM, M, NP, DM, EpiBf16{(bf16_t*)(ws + WS_ZX), NP, 1.f});
                 gemm_simple(F, (const bf16_t*)(ws + WS_MEMH), DM, (const bf16_t*)(ws + WS_WMKV), DM, MM, 2048, DM, EpiBf16{(bf16_t*)(ws + WS_KVM), 2048, 1.f}); SEAM(1); }
    if (IN(2)) { phase_rope(F); SEAM(2); }
    if (IN(3)) { phase_ssd_states(F); SEAM(3); }
    if (IN(4)) { phase_ssd_y(F); SEAM(4); }
    if (IN(5)) { phase_ssd_norm(F); SEAM(5); }
    if (IN(6)) { phase_diff_attn(F); SEAM(6); }
    if (IN(7)) { gemm_simple(F, (const bf16_t*)(ws + WS_Y), DM, (const bf16_t*)(ws + WS_WOUT), DM, M, DM, DM, EpiF32{(float*)(ws + WS_T), DM}); SEAM(7); }
    if (IN(8)) { phase_resid_norm(F, (const float*)(ws + WS_T), args.in[0], args.in[4], args.out, args.in[5], XN); SEAM(8); }
    if (IN(9)) { gemm_simple(F, XN, DM, (const bf16_t*)(ws + WS_WMQ), DM, M, DM, DM, EpiBf16{(bf16_t*)(ws + WS_QM), DM, C2_MEM}); SEAM(9); }
    if (IN(10)) { phase_cross_attn(F); SEAM(10); }
    if (IN(11)) { gemm_simple(F, (const bf16_t*)(ws + WS_OM), DM, (const bf16_t*)(ws + WS_WMO), DM, M, DM, DM, EpiF32{(float*)(ws + WS_T), DM}); SEAM(11); }
    if (IN(12)) { phase_resid_norm(F, (const float*)(ws + WS_T), args.out, args.in[7], args.out, args.in[8], XN); SEAM(12); }
    if (IN(13)) { gemm_simple(F, XN, DM, (const bf16_t*)(ws + WS_WUP), DM, M, DFF, DM, EpiRelu2{(bf16_t*)(ws + WS_H), DFF}); SEAM(13); }
    if (IN(14)) { gemm_simple(F, (const bf16_t*)(ws + WS_H), DFF, (const bf16_t*)(ws + WS_WDN), DFF, M, DM, DFF, EpiF32{(float*)(ws + WS_T2), DM}); SEAM(14); }
    if (IN(15)) { phase_resid_norm(F, (const float*)(ws + WS_T2), args.out, args.in[9], args.out, nullptr, nullptr); }
#undef IN
#undef SEAM
}

extern "C" void kernel_launch(void* const* d_in, const int* in_sizes, int n_in, void* d_out, int out_size, void* d_ws, size_t ws_size, hipStream_t stream) {
    static int grid = 0;
    if (grid == 0) {
        if (n_in != 29 || out_size != M * DM || ws_size < WS_END) { fprintf(stderr, "kernel_launch: unexpected shapes n_in %d out %d ws %zu\n", n_in, out_size, ws_size); grid = -1; return; }
        int dev = 0, cus = 0, per_cu = 0;
        hipGetDevice(&dev); hipDeviceGetAttribute(&cus, hipDeviceAttributeMultiprocessorCount, dev);
        hipFuncSetAttribute((const void*)mk_fwd, hipFuncAttributeMaxDynamicSharedMemorySize, LDS_BYTES);
        hipOccupancyMaxActiveBlocksPerMultiprocessor(&per_cu, (const void*)mk_fwd, NTHREADS, LDS_BYTES);
        if (per_cu < 1) per_cu = 1;
        grid = cus * per_cu;
        fprintf(stderr, "kernel_launch: cus %d per_cu %d grid %d\n", cus, per_cu, grid);
    }
    if (grid < 0) return;
    Args a{};
    for (int i = 0; i < 29; ++i) a.in[i] = (const float*)d_in[i];
    a.out = (float*)d_out; a.ws = (unsigned char*)d_ws;
#if MK_SINGLE
    a.ph_lo = 0; a.ph_hi = NPHASE; a.coop = 1;
    void* kargs[] = {&a};
    hipError_t e = hipLaunchCooperativeKernel((const void*)mk_fwd, dim3(grid), dim3(NTHREADS), kargs, LDS_BYTES, stream);
    if (e != hipSuccess) fprintf(stderr, "cooperative launch failed: %s (grid %d)\n", hipGetErrorString(e), grid);
#else
    for (int ph = 0; ph < NPHASE; ++ph) { a.ph_lo = ph; a.ph_hi = ph + 1; a.coop = 0; hipLaunchKernelGGL(mk_fwd, dim3(grid), dim3(NTHREADS), LDS_BYTES, stream, a); }
#endif
}
```

```cpp
#include <hip/hip_runtime.h>
#include <hip/hip_cooperative_groups.h>
#include <cstdio>
#include <cstdint>
namespace cg = cooperative_groups;

#ifndef MK_SINGLE
#define MK_SINGLE 1
#endif

constexpr int BATCH = 8, SEQ = 2048, DM = 1024, M = BATCH * SEQ, MEM_LEN = 256, MM = BATCH * MEM_LEN;
constexpr int D_SSD = 512, SSD_HD = 64, SSD_H = 8, SSD_N = 128, CHUNK = 128, NCH = SEQ / CHUNK;
constexpr int D_IN = 3080, NP = 3072;
constexpr int CZ = 0, CXBC = 512, CQ = 1536, CK = 2048, CV = 2560;
constexpr int DH = 4;
constexpr int MH = 4, MHD = 256, DFF = 4096;
constexpr float EPS = 1e-6f;
constexpr float LOG2E = 1.4426950408889634f;
constexpr float C2_DIFF = 0.125f * LOG2E;
constexpr float C2_MEM = 0.0625f * LOG2E;
constexpr float LAMBDA_INIT = 0.2f;

constexpr size_t MiB = 1u << 20;
constexpr size_t WS_WIN = 2 * MiB, WS_WOUT = 8 * MiB, WS_WMQ = 10 * MiB, WS_WMKV = 12 * MiB, WS_WMO = 16 * MiB, WS_WUP = 18 * MiB, WS_WDN = 26 * MiB;
constexpr size_t WS_DT = 37 * MiB, WS_SSQ = 37 * MiB + 512 * 1024, WS_COS = 38 * MiB, WS_SIN = 40 * MiB;
constexpr size_t WS_MEMH = 42 * MiB, WS_KVM = 46 * MiB, WS_ST = 54 * MiB, WS_DEC = 86 * MiB, WS_XN = 88 * MiB;
constexpr size_t WS_ZX = 128 * MiB, WS_Y = 224 * MiB, WS_T = 128 * MiB, WS_QM = 192 * MiB, WS_OM = 224 * MiB, WS_H = 128 * MiB, WS_T2 = 56 * MiB;
constexpr size_t WS_END = 256 * MiB;

constexpr int LDS_BYTES = 147456;
constexpr int NTHREADS = 512;

typedef unsigned short bf16_t;
typedef short bf16x8 __attribute__((ext_vector_type(8)));
typedef float f32x4 __attribute__((ext_vector_type(4)));

__device__ __forceinline__ float bf2f(bf16_t v) { return __uint_as_float(((unsigned)v) << 16); }
__device__ __forceinline__ bf16_t f2bf(float f) { unsigned u = __float_as_uint(f); return (bf16_t)((u + 0x7fffu + ((u >> 16) & 1u)) >> 16); }
__device__ __forceinline__ unsigned pk2(float lo, float hi) { return (unsigned)f2bf(lo) | ((unsigned)f2bf(hi) << 16); }
__device__ __forceinline__ float wave_sum(float v) {
#pragma unroll
    for (int o = 1; o < 64; o <<= 1) v += __shfl_xor(v, o);
    return v;
}
__device__ __forceinline__ float silu_f(float x) { return x / (1.f + expf(-x)); }
__device__ __forceinline__ float softplus_f(float x) { return x > 20.f ? x : log1pf(expf(x)); }

struct Args {
    const float* in[29];
    float* out;
    unsigned char* ws;
    int ph_lo, ph_hi, coop, pad;
};

struct Frame {
    unsigned char* lds;
    int tid, lane, wave, gw, ngw;
    const Args* a;
};

__device__ __forceinline__ void transpose_item(const float* W, int ldw, int src_col0, int K, bf16_t* WT, int n0, int k0, float* scr, int lane) {
#pragma unroll 8
    for (int i = 0; i < 32; ++i) { const int kk = 2 * i + (lane >> 5); scr[kk * 33 + (lane & 31)] = W[(size_t)(k0 + kk) * ldw + src_col0 + n0 + (lane & 31)]; }
    __builtin_amdgcn_wave_barrier();
    asm volatile("s_waitcnt lgkmcnt(0)" ::: "memory");
    const int c = lane & 7;
#pragma unroll
    for (int j = 0; j < 4; ++j) { const int n = (lane >> 3) + 8 * j; const float* s = scr + (8 * c) * 33 + n;
        uint4 o; o.x = pk2(s[0 * 33], s[1 * 33]); o.y = pk2(s[2 * 33], s[3 * 33]); o.z = pk2(s[4 * 33], s[5 * 33]); o.w = pk2(s[6 * 33], s[7 * 33]);
        *(uint4*)(WT + (size_t)(n0 + n) * K + k0 + 8 * c) = o; }
    asm volatile("s_waitcnt lgkmcnt(0)" ::: "memory");
    __builtin_amdgcn_wave_barrier();
}

__device__ __forceinline__ void rms_row(const float* xrow, const float* g, bf16_t* orow, int lane, f32x4 (&v)[4]) {
    const f32x4* xr = (const f32x4*)xrow + lane; const f32x4* gr = (const f32x4*)g + lane;
    float s = 0.f;
#pragma unroll
    for (int j = 0; j < 4; ++j) { v[j] = xr[64 * j]; s += (v[j].x * v[j].x + v[j].y * v[j].y) + (v[j].z * v[j].z + v[j].w * v[j].w); }
    const float r = 1.0f / sqrtf(wave_sum(s) * (1.f / DM) + EPS);
#pragma unroll
    for (int j = 0; j < 4; ++j) { const f32x4 gg = gr[64 * j]; v[j] = v[j] * r * gg;
        uint2 o; o.x = pk2(v[j].x, v[j].y); o.y = pk2(v[j].z, v[j].w); *((uint2*)orow + lane + 64 * j) = o; }
}

__device__ __forceinline__ void phase_prologue(Frame& F) {
    const Args& A = *F.a; unsigned char* ws = A.ws;
    float* scr = (float*)(F.lds + F.wave * 8704);
    float* dtw = (float*)(F.lds + 73728);
    for (int e = F.tid; e < 1024 * 8; e += NTHREADS) dtw[e] = A.in[10][(size_t)(e >> 3) * D_IN + 1536 + (e & 7)];
    constexpr int I_IN = 16 * 96, I_SQ = 16 * 32, I_UP = 16 * 128, I_DN = 64 * 32;
    constexpr int NITEMS = I_IN + 5 * I_SQ + I_UP + I_DN;
    for (int it = F.gw; it < NITEMS; it += F.ngw) {
        int r = it;
        if (r < I_IN) { const int nb = r % 96, kb = r / 96; const int n0 = nb * 32; transpose_item(A.in[10], D_IN, n0 >= 1536 ? 8 : 0, 1024, (bf16_t*)(ws + WS_WIN), n0, kb * 64, scr, F.lane); continue; } r -= I_IN;
        if (r < I_SQ) { transpose_item(A.in[22], 1024, 0, 1024, (bf16_t*)(ws + WS_WOUT), (r % 32) * 32, (r / 32) * 64, scr, F.lane); continue; } r -= I_SQ;
        if (r < I_SQ) { transpose_item(A.in[23], 1024, 0, 1024, (bf16_t*)(ws + WS_WMQ), (r % 32) * 32, (r / 32) * 64, scr, F.lane); continue; } r -= I_SQ;
        if (r < I_SQ) { transpose_item(A.in[24], 1024, 0, 1024, (bf16_t*)(ws + WS_WMKV), (r % 32) * 32, (r / 32) * 64, scr, F.lane); continue; } r -= I_SQ;
        if (r < I_SQ) { transpose_item(A.in[25], 1024, 0, 1024, (bf16_t*)(ws + WS_WMKV) + (size_t)1024 * 1024, (r % 32) * 32, (r / 32) * 64, scr, F.lane); continue; } r -= I_SQ;
        if (r < I_SQ) { transpose_item(A.in[26], 1024, 0, 1024, (bf16_t*)(ws + WS_WMO), (r % 32) * 32, (r / 32) * 64, scr, F.lane); continue; } r -= I_SQ;
        if (r < I_UP) { transpose_item(A.in[27], 4096, 0, 1024, (bf16_t*)(ws + WS_WUP), (r % 128) * 32, (r / 128) * 64, scr, F.lane); continue; } r -= I_UP;
        transpose_item(A.in[28], 1024, 0, 4096, (bf16_t*)(ws + WS_WDN), (r % 32) * 32, (r / 32) * 64, scr, F.lane);
    }
    __syncthreads();
    for (int m = F.gw; m < M; m += F.ngw) {
        f32x4 v[4];
        rms_row(A.in[0] + (size_t)m * DM, A.in[3], (bf16_t*)(ws + WS_XN) + (size_t)m * DM, F.lane, v);
        float acc[8];
#pragma unroll
        for (int h = 0; h < 8; ++h) acc[h] = 0.f;
#pragma unroll 1
        for (int j = 0; j < 4; ++j)
#pragma unroll
            for (int e = 0; e < 4; ++e) { const int k = 256 * j + 4 * F.lane + e; const f32x4 w0 = *(const f32x4*)(dtw + k * 8), w1 = *(const f32x4*)(dtw + k * 8 + 4); const float hv = v[j][e];
                acc[0] += hv * w0.x; acc[1] += hv * w0.y; acc[2] += hv * w0.z; acc[3] += hv * w0.w; acc[4] += hv * w1.x; acc[5] += hv * w1.y; acc[6] += hv * w1.z; acc[7] += hv * w1.w; }
#pragma unroll
        for (int h = 0; h < 8; ++h) acc[h] = wave_sum(acc[h]);
        if (F.lane == 0) { float* d = (float*)(ws + WS_DT) + (size_t)m * 8;
#pragma unroll
            for (int h = 0; h < 8; ++h) d[h] = acc[h]; }
    }
    for (int m = F.gw; m < MM; m += F.ngw) { f32x4 v[4]; rms_row(A.in[1] + (size_t)m * DM, A.in[6], (bf16_t*)(ws + WS_MEMH) + (size_t)m * DM, F.lane, v); }
    { const int gt = blockIdx.x * NTHREADS + F.tid, ngt = gridDim.x * NTHREADS; const int* pos = (const int*)A.in[2];
      float* C = (float*)(ws + WS_COS); float* S = (float*)(ws + WS_SIN);
      for (int e = gt; e < M * 32; e += ngt) { const int t = e >> 5, i = e & 31; const float inv = powf(10000.f, -(float)i / 32.f); const float ang = (float)pos[t] * inv; float sn, cs; sincosf(ang, &sn, &cs); C[e] = cs; S[e] = sn; } }
}

struct EpiBf16 { bf16_t* O; int ldc; float scale;
    __device__ __forceinline__ void operator()(int row, int col, f32x4 v) const { uint2 o; o.x = pk2(v.x * scale, v.y * scale); o.y = pk2(v.z * scale, v.w * scale); *(uint2*)(O + (size_t)row * ldc + col) = o; } };
struct EpiF32 { float* O; int ldc;
    __device__ __forceinline__ void operator()(int row, int col, f32x4 v) const { *(f32x4*)(O + (size_t)row * ldc + col) = v; } };
struct EpiRelu2 { bf16_t* O; int ldc;
    __device__ __forceinline__ void operator()(int row, int col, f32x4 v) const { float a = fmaxf(v.x, 0.f), b = fmaxf(v.y, 0.f), c = fmaxf(v.z, 0.f), d = fmaxf(v.w, 0.f);
        uint2 o; o.x = pk2(a * a, b * b); o.y = pk2(c * c, d * d); *(uint2*)(O + (size_t)row * ldc + col) = o; } };

template <class Epi>
__device__ __forceinline__ void gemm_simple(Frame& F, const bf16_t* A, int lda, const bf16_t* Bt, int ldb, int Mr, int Nc, int K, const Epi& E) {
    bf16_t* As = (bf16_t*)F.lds; bf16_t* Bs = As + 128 * 40;
    const int tid = F.tid, lane = F.lane, wid = F.wave, wr = wid >> 2, wc = wid & 3, fr = lane & 15, fq = lane >> 4;
    const int ntn = Nc / 128, ntiles = (Mr / 128) * ntn;
    for (int u = blockIdx.x; u < ntiles; u += gridDim.x) {
        const int tm = u / ntn, tn = u % ntn;
        f32x4 acc[4][2];
#pragma unroll
        for (int m = 0; m < 4; ++m)
#pragma unroll
            for (int n = 0; n < 2; ++n) acc[m][n] = (f32x4){0.f, 0.f, 0.f, 0.f};
        const bf16_t* Ag = A + (size_t)(tm * 128 + (tid >> 2)) * lda + (tid & 3) * 8;
        const bf16_t* Bg = Bt + (size_t)(tn * 128 + (tid >> 2)) * ldb + (tid & 3) * 8;
        for (int k0 = 0; k0 < K; k0 += 32) {
            const uint4 va = *(const uint4*)(Ag + k0), vb = *(const uint4*)(Bg + k0);
            __syncthreads();
            *(uint4*)(As + (tid >> 2) * 40 + (tid & 3) * 8) = va;
            *(uint4*)(Bs + (tid >> 2) * 40 + (tid & 3) * 8) = vb;
            __syncthreads();
            bf16x8 af[4], bfr[2];
#pragma unroll
            for (int m = 0; m < 4; ++m) af[m] = *(const bf16x8*)(As + (wr * 64 + m * 16 + fr) * 40 + fq * 8);
#pragma unroll
            for (int n = 0; n < 2; ++n) bfr[n] = *(const bf16x8*)(Bs + (wc * 32 + n * 16 + fr) * 40 + fq * 8);
#pragma unroll
            for (int m = 0; m < 4; ++m)
#pragma unroll
                for (int n = 0; n < 2; ++n) acc[m][n] = __builtin_amdgcn_mfma_f32_16x16x32_bf16(bfr[n], af[m], acc[m][n], 0, 0, 0);
        }
#pragma unroll
        for (int m = 0; m < 4; ++m)
#pragma unroll
            for (int n = 0; n < 2; ++n) E(tm * 128 + wr * 64 + m * 16 + fr, tn * 128 + wc * 32 + n * 16 + fq * 4, acc[m][n]);
    }
    __syncthreads();
}

namespace pg8 {
#define PG8_LAS __attribute__((address_space(3)))
typedef unsigned short bf16_t;
typedef short bf16x8 __attribute__((ext_vector_type(8)));
typedef float f32x4 __attribute__((ext_vector_type(4)));
typedef unsigned u32x4 __attribute__((ext_vector_type(4)));
constexpr int BM = 256, BK = 64, HALF = 128, HTB = HALF * BK * 2  , STAGE_BYTES = 8 * HTB, NXCD = 8, WGM = 8;

__host__ __device__ __forceinline__ int lds_byte(int r, int c) { const int st = (r >> 4) * 2 + (c >> 5), rr = r & 15, cc = c & 31, ob = rr * 64 + cc * 2; return st * 1024 + (ob ^ (((ob >> 9) & 1) << 5)); }
__host__ __device__ __forceinline__ void stage_rc(int b, int& R, int& C) { const int st = b / 1024, sb = b % 1024, swz = sb ^ (((sb >> 9) & 1) << 5); R = (st >> 1) * 16 + swz / 64; C = (st & 1) * 32 + (swz % 64) / 2; }
__host__ __device__ __forceinline__ int perm32(int rho) { const int n = rho >> 4, i = rho & 15; return 8 * (i >> 2) + 4 * n + (i & 3); }

struct Unit { int pm, pn; };
struct Gemm { const bf16_t* A; const bf16_t* Bt; int M, N, K; };

struct StaticOrder {
    int nM, nN, nwg, G, c;
    __host__ __device__ void init(int M, int N, int G_, int c_) { nM = M / BM; nN = N / BM; nwg = nM * nN; G = G_; c = c_; }
    __host__ __device__ bool next(int i, Unit& u) const {
        const long L = (long)i * G + c; if (L >= nwg) return false;
        int wgid = (int)L; { const int q = nwg / NXCD, r = nwg % NXCD, xcd = wgid % NXCD, off = wgid / NXCD; wgid = (xcd < r ? xcd * (q + 1) : r * (q + 1) + (xcd - r) * q) + off; }
        const int nig = WGM * nN, gid = wgid / nig, fm = gid * WGM, gsz = (nM - fm) < WGM ? (nM - fm) : WGM;
        u.pm = fm + ((wgid % nig) % gsz); u.pn = (wgid % nig) / gsz; return true;
    }
    __device__ __forceinline__ void a_ready(const Unit&) const {}
    __device__ __forceinline__ void done(const Unit&) const {}
};
__device__ __forceinline__ unsigned cvt_pk_bf16(float lo, float hi) { unsigned r; asm volatile("v_cvt_pk_bf16_f32 %0, %1, %2" : "=v"(r) : "v"(lo), "v"(hi)); return r; }
typedef float f32x2 __attribute__((ext_vector_type(2)));

template <class Fn> struct EpiGen {
    static constexpr bool PERM = false, AFTER_DRAIN = false; Fn fn;
    __device__ __forceinline__ void operator()(const f32x4 (&acc)[2][2][4][2], const Unit& u, int wr, int wc, int fr, int fq) const {
#pragma unroll
        for (int ai = 0; ai < 2; ++ai)
#pragma unroll
            for (int m = 0; m < 4; ++m)
#pragma unroll
                for (int bj = 0; bj < 2; ++bj)
#pragma unroll
                    for (int n = 0; n < 2; ++n) fn(u.pm * BM + ai * HALF + wr * 64 + m * 16 + fr, u.pn * BM + bj * HALF + wc * 32 + n * 16 + fq * 4, acc[ai][bj][m][n]);
    }
};
template <class Epi, class Sched, bool ALIGN_EPI = false, bool SP2 = false>
__device__ __forceinline__ void gemm_phase(PG8_LAS unsigned char* lds, const Gemm g, const Sched& S, const Epi& E) {
    const int tid = threadIdx.x, wid = __builtin_amdgcn_readfirstlane(tid >> 6), lane = tid & 63, wr = wid >> 2, wc = wid & 3, fr = lane & 15, fq = lane >> 4;
    const int K = g.K, nt = K / BK;
    unsigned voffA[2], voffB[2];
#pragma unroll
    for (int i = 0; i < 2; ++i) { int R, C; stage_rc(tid * 16 + i * 8192, R, C); const int Rb = Epi::PERM ? ((R & ~31) + perm32(R & 31)) : R;
        voffA[i] = (unsigned)(R * K + C) * 2u; voffB[i] = (unsigned)(Rb * K + C) * 2u; }
    const size_t kstep = (size_t)(BK * 2);
    const size_t hstep = (size_t)HALF * K * 2;
    const size_t tstep = 2 * hstep;
    const unsigned ldsw = (unsigned)wid * 1024u;
    const int aoff = lds_byte(wr * 64 + fr, fq * 8), boff = lds_byte(wc * 32 + fr, fq * 8);
#define PG8_SA(b, h) (((b) * 2 + (h)) * HTB)
#define PG8_SB(b, h) ((4 + (b) * 2 + (h)) * HTB)
#define PG8_STAGE(bufoff, gbase, voff) do { _Pragma("unroll") for (int _i = 0; _i < 2; ++_i) \
        __builtin_amdgcn_global_load_lds((const unsigned*)((const char*)(gbase) + (voff)[_i]), (PG8_LAS unsigned*)(lds + (bufoff) + ldsw + _i * 8192), 16, 0, 0); } while (0)
#define PG8_LDA(dst, b, h) do { _Pragma("unroll") for (int m = 0; m < 4; ++m) _Pragma("unroll") for (int k = 0; k < 2; ++k) dst[m][k] = *(const PG8_LAS bf16x8*)(lds + PG8_SA(b, h) + aoff + m * 2048 + k * 1024); } while (0)
#define PG8_LDB(dst, b, h) do { _Pragma("unroll") for (int n = 0; n < 2; ++n) _Pragma("unroll") for (int k = 0; k < 2; ++k) dst[n][k] = *(const PG8_LAS bf16x8*)(lds + PG8_SB(b, h) + boff + n * 2048 + k * 1024); } while (0)
#define PG8_MMA(ai, bj, At, Bt) do { __builtin_amdgcn_s_setprio(1); _Pragma("unroll") for (int m = 0; m < 4; ++m) _Pragma("unroll") for (int n = 0; n < 2; ++n) _Pragma("unroll") for (int k = 0; k < 2; ++k) \
        acc[ai][bj][m][n] = __builtin_amdgcn_mfma_f32_16x16x32_bf16(Bt[n][k], At[m][k], acc[ai][bj][m][n], 0, 0, 0); __builtin_amdgcn_s_setprio(0); } while (0)
#define PG8_WAIT_V(n) asm volatile("s_waitcnt vmcnt(" #n ")" ::: "memory")
#define PG8_WAIT_L(n) asm volatile("s_waitcnt lgkmcnt(" #n ")" ::: "memory")
#define PG8_BAR __builtin_amdgcn_s_barrier()
#define PG8_SCHED __builtin_amdgcn_sched_barrier(0)
    Unit cur, nxt; int ui = 0;
    if (!S.next(0, cur)) return;
    f32x4 acc[2][2][4][2];
#pragma unroll
    for (int a = 0; a < 2; ++a)
#pragma unroll
        for (int b = 0; b < 2; ++b)
#pragma unroll
            for (int m = 0; m < 4; ++m)
#pragma unroll
                for (int n = 0; n < 2; ++n) acc[a][b][m][n] = (f32x4){0.f, 0.f, 0.f, 0.f};
    bf16x8 At[4][2], B0[2][2], B1[2][2];
    const char* cA = (const char*)g.A + (size_t)cur.pm * tstep; const char* cB = (const char*)g.Bt + (size_t)cur.pn * tstep;
    S.a_ready(cur);
    if constexpr (SP2) {
        PG8_STAGE(PG8_SB(0, 0), cB, voffB); PG8_STAGE(PG8_SB(0, 1), cB + hstep, voffB); PG8_STAGE(PG8_SA(0, 0), cA, voffA); PG8_STAGE(PG8_SA(0, 1), cA + hstep, voffA);
        if (wr == 1) PG8_BAR;
        PG8_WAIT_V(2); PG8_BAR;
        PG8_STAGE(PG8_SB(1, 0), cB + kstep, voffB); PG8_STAGE(PG8_SA(1, 0), cA + kstep, voffA); PG8_STAGE(PG8_SB(1, 1), cB + hstep + kstep, voffB);
        PG8_WAIT_V(6); PG8_BAR;
    } else {
        PG8_STAGE(PG8_SB(0, 0), cB, voffB); PG8_STAGE(PG8_SA(0, 0), cA, voffA); PG8_STAGE(PG8_SB(0, 1), cB + hstep, voffB); PG8_STAGE(PG8_SA(0, 1), cA + hstep, voffA);
        if (wr == 1) PG8_BAR;
        PG8_WAIT_V(4); PG8_BAR;
        PG8_STAGE(PG8_SB(1, 0), cB + kstep, voffB); PG8_STAGE(PG8_SA(1, 0), cA + kstep, voffA); PG8_STAGE(PG8_SB(1, 1), cB + hstep + kstep, voffB);
        PG8_WAIT_V(6); PG8_BAR;
    }
    for (;;) {
        const bool has_next = S.next(ui + 1, nxt);
        const char* nA = has_next ? (const char*)g.A + (size_t)nxt.pm * tstep : cA; const char* nB = has_next ? (const char*)g.Bt + (size_t)nxt.pn * tstep : cB;
        for (int t = 0; t < nt; t += 2) {
            const bool last = (t == nt - 2);
            const char* a1 = cA + (size_t)(t + 1) * kstep;
            const char* a2 = last ? nA : cA + (size_t)(t + 2) * kstep; const char* b2 = last ? nB : cB + (size_t)(t + 2) * kstep;
            const char* a3 = a2 + kstep; const char* b3 = b2 + kstep;
            if (last && has_next) S.a_ready(nxt);
            if constexpr (SP2) {
            PG8_LDB(B0, 0, 0); PG8_LDB(B1, 0, 1); PG8_SCHED; PG8_LDA(At, 0, 0); PG8_STAGE(PG8_SA(1, 1), a1 + hstep, voffA);
            PG8_WAIT_V(8); PG8_WAIT_L(0); PG8_BAR; PG8_MMA(0, 0, At, B0); PG8_MMA(0, 1, At, B1); PG8_BAR; PG8_SCHED;
            PG8_LDA(At, 0, 1); PG8_STAGE(PG8_SB(0, 0), b2, voffB); PG8_STAGE(PG8_SB(0, 1), b2 + hstep, voffB); PG8_STAGE(PG8_SA(0, 0), a2, voffA);
            PG8_WAIT_V(8); PG8_WAIT_L(0); PG8_BAR; PG8_MMA(1, 0, At, B0); PG8_MMA(1, 1, At, B1); PG8_BAR; PG8_SCHED;
            PG8_LDB(B0, 1, 0); PG8_LDB(B1, 1, 1); PG8_SCHED; PG8_LDA(At, 1, 0); PG8_STAGE(PG8_SA(0, 1), a2 + hstep, voffA);
            PG8_WAIT_V(8); PG8_WAIT_L(0); PG8_BAR; PG8_MMA(0, 0, At, B0); PG8_MMA(0, 1, At, B1); PG8_BAR; PG8_SCHED;
            PG8_LDA(At, 1, 1); PG8_STAGE(PG8_SB(1, 0), b3, voffB); PG8_STAGE(PG8_SB(1, 1), b3 + hstep, voffB); PG8_STAGE(PG8_SA(1, 0), a3, voffA);
            PG8_WAIT_V(8); PG8_WAIT_L(0); PG8_BAR; PG8_MMA(1, 0, At, B0); PG8_MMA(1, 1, At, B1); PG8_BAR; PG8_SCHED;
            } else {
            PG8_LDB(B0, 0, 0); PG8_SCHED; PG8_LDA(At, 0, 0); PG8_STAGE(PG8_SA(1, 1), a1 + hstep, voffA);
            PG8_WAIT_L(8); PG8_BAR; PG8_WAIT_L(0); PG8_MMA(0, 0, At, B0); PG8_BAR; PG8_SCHED;
            PG8_LDB(B1, 0, 1); PG8_STAGE(PG8_SB(0, 0), b2, voffB);
            PG8_BAR; PG8_WAIT_L(0); PG8_MMA(0, 1, At, B1); PG8_BAR;
            PG8_LDA(At, 0, 1); PG8_STAGE(PG8_SA(0, 0), a2, voffA);
            PG8_BAR; PG8_WAIT_L(0); PG8_MMA(1, 0, At, B0); PG8_BAR; PG8_SCHED;
            PG8_STAGE(PG8_SB(0, 1), b2 + hstep, voffB);
            PG8_WAIT_V(6); PG8_BAR; PG8_MMA(1, 1, At, B1); PG8_BAR;
            PG8_LDB(B0, 1, 0); PG8_SCHED; PG8_LDA(At, 1, 0); PG8_STAGE(PG8_SA(0, 1), a2 + hstep, voffA);
            PG8_WAIT_L(8); PG8_BAR; PG8_WAIT_L(0); PG8_MMA(0, 0, At, B0); PG8_BAR; PG8_SCHED;
            PG8_LDB(B1, 1, 1); PG8_STAGE(PG8_SB(1, 0), b3, voffB);
            PG8_BAR; PG8_WAIT_L(0); PG8_MMA(0, 1, At, B1); PG8_BAR;
            PG8_LDA(At, 1, 1); PG8_STAGE(PG8_SA(1, 0), a3, voffA);
            PG8_BAR; PG8_WAIT_L(0); PG8_MMA(1, 0, At, B0); PG8_BAR; PG8_SCHED;
            PG8_STAGE(PG8_SB(1, 1), b3 + hstep, voffB);
            PG8_WAIT_V(6); PG8_BAR; PG8_MMA(1, 1, At, B1); PG8_BAR;
            }
        }
        if constexpr (ALIGN_EPI) { if (wr == 0) PG8_BAR; }
        if constexpr (!Epi::AFTER_DRAIN) { E(acc, cur, wr, wc, fr, fq); S.done(cur); }
        if (!has_next) break;
#pragma unroll
        for (int a = 0; a < 2; ++a)
#pragma unroll
            for (int b = 0; b < 2; ++b)
#pragma unroll
                for (int m = 0; m < 4; ++m)
#pragma unroll
                    for (int n = 0; n < 2; ++n) acc[a][b][m][n] = (f32x4){0.f, 0.f, 0.f, 0.f};
        cur = nxt; cA = nA; cB = nB; ++ui;
        if constexpr (ALIGN_EPI) { if (wr == 1) PG8_BAR; }
    }
    PG8_WAIT_V(0);
    if constexpr (!ALIGN_EPI) { if (wr == 0) PG8_BAR; }
    PG8_BAR;
    if constexpr (Epi::AFTER_DRAIN) { E.fused(acc, cur, wr, wc, fr, fq, lds, wid, lane); S.done(cur); }
#undef PG8_SA
#undef PG8_SB
#undef PG8_STAGE
#undef PG8_LDA
#undef PG8_LDB
#undef PG8_MMA
#undef PG8_WAIT_V
#undef PG8_WAIT_L
#undef PG8_BAR
#undef PG8_SCHED
}
}
#define PG8_SP2 true
#define PG8_ALIGN true
__device__ __forceinline__ void phase_rope(Frame& F) {
    unsigned char* ws = F.a->ws; bf16_t* ZX = (bf16_t*)(ws + WS_ZX); const float* C = (const float*)(ws + WS_COS); const float* S = (const float*)(ws + WS_SIN);
    for (int t = F.gw; t < M; t += F.ngw) {
        bf16_t* row = ZX + (size_t)t * NP;
#pragma unroll
        for (int j = 0; j < 8; ++j) { const int idx = F.lane + 64 * j; const int tensor = idx >> 8, grp = (idx >> 5) & 7, i = idx & 31;
            const int cl = (tensor ? CK : CQ) + grp * 64 + i; const float cs = C[t * 32 + i], sn = S[t * 32 + i];
            const float x1 = bf2f(row[cl]), x2 = bf2f(row[cl + 32]); const float sc = tensor ? 1.f : C2_DIFF;
            row[cl] = f2bf((x1 * cs - x2 * sn) * sc); row[cl + 32] = f2bf((x2 * cs + x1 * sn) * sc); }
    }
}

template <class Fn>
__device__ __forceinline__ void ssd_conv(Frame& F, int b, int c, int xc0, int ncols, const Fn& fn) {
    const bf16_t* ZX = (const bf16_t*)(F.a->ws + WS_ZX); const float* cw = F.a->in[11]; const float* cb = F.a->in[12];
    for (int e = F.tid; e < 128 * ncols; e += NTHREADS) { const int l = e / ncols, j = e % ncols, xc = xc0 + j; const int s = c * CHUNK + l;
        float acc = cb[xc];
#pragma unroll
        for (int w = 0; w < 4; ++w) { const int ss = s - 3 + w; if (ss >= 0) acc += cw[w * 1024 + xc] * bf2f(ZX[(size_t)(b * SEQ + ss) * NP + CXBC + xc]); }
        fn(l, j, silu_f(acc)); }
}
__device__ __forceinline__ void ssd_dt_cum(Frame& F, int b, int c, int h, float* dtl, float* cuml) {
    const float* DT = (const float*)(F.a->ws + WS_DT);
    if (F.tid < 128) { const float dt = softplus_f(DT[(size_t)(b * SEQ + c * CHUNK + F.tid) * 8 + h] + F.a->in[13][h]); const float a = -expf(F.a->in[14][h]); dtl[F.tid] = dt; cuml[F.tid] = dt * a; }
    __syncthreads();
    if (F.tid == 0) { float s = 0.f; for (int l = 0; l < 128; ++l) { s += cuml[l]; cuml[l] = s; } }
    __syncthreads();
}
__device__ __forceinline__ void phase_ssd_states(Frame& F) {
    float* xw = (float*)F.lds; float* Bm = (float*)(F.lds + 32768); float* dtl = (float*)(F.lds + 98304); float* cuml = dtl + 128;
    float* ST = (float*)(F.a->ws + WS_ST); float* DEC = (float*)(F.a->ws + WS_DEC);
    for (int u = blockIdx.x; u < BATCH * NCH * SSD_H; u += gridDim.x) {
        const int h = u & 7, c = (u >> 3) & 15, b = u >> 7, g = h >> 2;
        ssd_dt_cum(F, b, c, h, dtl, cuml);
        const float clast = cuml[127];
        ssd_conv(F, b, c, h * 64, 64, [&](int l, int j, float v) { xw[l * 64 + j] = v * dtl[l] * expf(clast - cuml[l]); });
        ssd_conv(F, b, c, 512 + g * 128, 128, [&](int l, int j, float v) { Bm[l * 128 + j] = bf2f(f2bf(v)); });
        __syncthreads();
        const int p = F.tid >> 3, n0 = (F.tid & 7) * 16;
        float acc[16];
#pragma unroll
        for (int i = 0; i < 16; ++i) acc[i] = 0.f;
        for (int l = 0; l < 128; ++l) { const float xv = xw[l * 64 + p];
#pragma unroll
            for (int i = 0; i < 16; ++i) acc[i] += xv * Bm[l * 128 + n0 + i]; }
        float* dst = ST + ((size_t)u * 64 + p) * 128 + n0;
#pragma unroll
        for (int i = 0; i < 16; i += 4) *(f32x4*)(dst + i) = (f32x4){acc[i], acc[i + 1], acc[i + 2], acc[i + 3]};
        if (F.tid == 0) DEC[u] = expf(clast);
        __syncthreads();
    }
}
__device__ __forceinline__ void phase_ssd_y(Frame& F) {
    bf16_t* Cb = (bf16_t*)F.lds; bf16_t* Bb = (bf16_t*)(F.lds + 32768); float* Hin = (float*)(F.lds + 32768); bf16_t* Mb = (bf16_t*)(F.lds + 65536);
    float* xs = (float*)(F.lds + 98304); float* dtl = (float*)(F.lds + 131072); float* cuml = dtl + 128;
    const float* ST = (const float*)(F.a->ws + WS_ST); const float* DEC = (const float*)(F.a->ws + WS_DEC);
    const bf16_t* ZX = (const bf16_t*)(F.a->ws + WS_ZX); bf16_t* Y = (bf16_t*)(F.a->ws + WS_Y); float* SSQ = (float*)(F.a->ws + WS_SSQ);
    for (int u = blockIdx.x; u < BATCH * NCH * SSD_H; u += gridDim.x) {
        const int h = u & 7, c = (u >> 3) & 15, b = u >> 7, g = h >> 2;
        ssd_dt_cum(F, b, c, h, dtl, cuml);
        ssd_conv(F, b, c, h * 64, 64, [&](int l, int j, float v) { xs[l * 64 + j] = bf2f(f2bf(v)); });
        ssd_conv(F, b, c, 512 + g * 128, 128, [&](int l, int j, float v) { Bb[l * 128 + j] = f2bf(v); });
        ssd_conv(F, b, c, 768 + g * 128, 128, [&](int l, int j, float v) { Cb[l * 128 + j] = f2bf(v); });
        __syncthreads();
        {
            const int l = F.tid >> 2; const float cl = cuml[l];
#pragma unroll 1
            for (int half = 0; half < 2; ++half) {
                const int s0 = (F.tid & 3) * 32 + half * 16;
                float acc[16];
#pragma unroll
                for (int i = 0; i < 16; ++i) acc[i] = 0.f;
#pragma unroll 1
                for (int nb = 0; nb < 16; ++nb) {
                    const bf16x8 c8 = *(const bf16x8*)(Cb + l * 128 + nb * 8); float cf[8];
#pragma unroll
                    for (int q = 0; q < 8; ++q) cf[q] = bf2f((bf16_t)c8[q]);
#pragma unroll
                    for (int i = 0; i < 16; ++i) { const bf16x8 b8 = *(const bf16x8*)(Bb + (s0 + i) * 128 + nb * 8);
#pragma unroll
                        for (int q = 0; q < 8; ++q) acc[i] += cf[q] * bf2f((bf16_t)b8[q]); }
                }
#pragma unroll
                for (int i = 0; i < 16; ++i) { const int s = s0 + i; Mb[l * 128 + s] = f2bf(s <= l ? acc[i] * expf(cl - cuml[s]) * dtl[s] : 0.f); }
            }
        }
        __syncthreads();
        {
            const int p = F.tid >> 3, n0 = (F.tid & 7) * 16;
            float hc[16];
#pragma unroll
            for (int i = 0; i < 16; ++i) hc[i] = 0.f;
            for (int j = 0; j < c; ++j) { const int uj = (b * NCH + j) * 8 + h; const float d = DEC[uj]; const float* src = ST + ((size_t)uj * 64 + p) * 128 + n0;
#pragma unroll
                for (int i = 0; i < 16; i += 4) { const f32x4 sv = *(const f32x4*)(src + i); hc[i] = hc[i] * d + sv.x; hc[i + 1] = hc[i + 1] * d + sv.y; hc[i + 2] = hc[i + 2] * d + sv.z; hc[i + 3] = hc[i + 3] * d + sv.w; } }
#pragma unroll
            for (int i = 0; i < 16; ++i) Hin[(n0 + i) * 64 + p] = hc[i];
        }
        __syncthreads();
        {
            const int l = F.tid >> 2, p0 = (F.tid & 3) * 16;
            float yd[16], yo[16];
#pragma unroll
            for (int i = 0; i < 16; ++i) { yd[i] = 0.f; yo[i] = 0.f; }
            for (int s = 0; s <= l; ++s) { const float mv = bf2f(Mb[l * 128 + s]);
#pragma unroll
                for (int i = 0; i < 16; ++i) yd[i] += mv * xs[s * 64 + p0 + i]; }
            for (int n = 0; n < 128; ++n) { const float cv = bf2f(Cb[l * 128 + n]);
#pragma unroll
                for (int i = 0; i < 16; ++i) yo[i] += cv * Hin[n * 64 + p0 + i]; }
            const float ec = expf(cuml[l]), dsk = F.a->in[15][h]; const size_t t = (size_t)(b * SEQ + c * CHUNK + l);
            float ssq = 0.f; float vv[16];
#pragma unroll
            for (int i = 0; i < 16; ++i) { const float y = yd[i] + ec * yo[i] + dsk * xs[l * 64 + p0 + i]; const float z = bf2f(ZX[t * NP + CZ + h * 64 + p0 + i]); const float v = y * silu_f(z); vv[i] = v; ssq += v * v; }
            ssq += __shfl_xor(ssq, 1); ssq += __shfl_xor(ssq, 2);
            bf16_t* yo_p = Y + t * DM + h * 64 + p0;
#pragma unroll
            for (int i = 0; i < 16; i += 4) { uint2 o; o.x = pk2(vv[i], vv[i + 1]); o.y = pk2(vv[i + 2], vv[i + 3]); *(uint2*)(yo_p + i) = o; }
            if ((F.tid & 3) == 0) SSQ[t * 8 + h] = ssq;
        }
        __syncthreads();
    }
}
__device__ __forceinline__ void phase_ssd_norm(Frame& F) {
    bf16_t* Y = (bf16_t*)(F.a->ws + WS_Y); const float* SSQ = (const float*)(F.a->ws + WS_SSQ); const float* w = F.a->in[16];
    for (int t = F.gw; t < M; t += F.ngw) {
        float s = 0.f;
#pragma unroll
        for (int h = 0; h < 8; ++h) s += SSQ[(size_t)t * 8 + h];
        const float r = 1.0f / sqrtf(s * (1.f / D_SSD) + EPS);
        bf16_t* row = Y + (size_t)t * DM;
#pragma unroll
        for (int j = 0; j < 2; ++j) { const int col = (F.lane + 64 * j) * 4; uint2 o = *(uint2*)(row + col); const f32x4 wv = *(const f32x4*)(w + col);
            const float a0 = bf2f((bf16_t)(o.x & 0xffff)) * r * wv.x, a1 = bf2f((bf16_t)(o.x >> 16)) * r * wv.y, a2 = bf2f((bf16_t)(o.y & 0xffff)) * r * wv.z, a3 = bf2f((bf16_t)(o.y >> 16)) * r * wv.w;
            o.x = pk2(a0, a1); o.y = pk2(a2, a3); *(uint2*)(row + col) = o; }
    }
}

__device__ __forceinline__ void phase_diff_attn(Frame& F) {
    float* Ks = (float*)F.lds; float* Vs = (float*)(F.lds + 32768); float* Ot = (float*)(F.lds + 65536);
    const bf16_t* ZX = (const bf16_t*)(F.a->ws + WS_ZX); bf16_t* Y = (bf16_t*)(F.a->ws + WS_Y);
    const int pair = F.tid >> 2, row = pair & 63, comp = pair >> 6, sub = F.tid & 3;
    const int NU = BATCH * DH * (SEQ / 64);
    for (int uu = blockIdx.x; uu < NU; uu += gridDim.x) {
        const int qblk = 31 - (uu / (BATCH * DH)), bh = uu % (BATCH * DH), b = bh / DH, h = bh % DH;
        const int qidx = qblk * 64 + row; const size_t tq = (size_t)b * SEQ + qidx;
        float q[16];
#pragma unroll
        for (int i = 0; i < 16; ++i) q[i] = bf2f(ZX[tq * NP + CQ + h * 128 + comp * 64 + sub * 16 + i]);
        float o[32];
#pragma unroll
        for (int i = 0; i < 32; ++i) o[i] = 0.f;
        float mrun = -INFINITY, lrun = 0.f;
        for (int kt = 0; kt <= qblk; ++kt) {
            __syncthreads();
            for (int e = F.tid; e < 8192; e += NTHREADS) { const int cp = e >> 12, j = (e >> 6) & 63, d = e & 63; Ks[e] = bf2f(ZX[((size_t)b * SEQ + kt * 64 + j) * NP + CK + h * 128 + cp * 64 + d]); }
            for (int e = F.tid; e < 8192; e += NTHREADS) { const int j = e >> 7, d = e & 127; Vs[e] = bf2f(ZX[((size_t)b * SEQ + kt * 64 + j) * NP + CV + h * 128 + d]); }
            __syncthreads();
            _Pragma("unroll 1") for (int jb = 0; jb < 8; ++jb) {
                float s[8];
#pragma unroll
                for (int jj = 0; jj < 8; ++jj) { const float* kr = Ks + comp * 4096 + (jb * 8 + jj) * 64 + sub * 16; float a = 0.f;
#pragma unroll
                    for (int i = 0; i < 16; ++i) a += q[i] * kr[i];
                    a += __shfl_xor(a, 1); a += __shfl_xor(a, 2);
                    const int kidx = kt * 64 + jb * 8 + jj; s[jj] = (kidx > qidx) ? -INFINITY : a; }
                float mx = s[0];
#pragma unroll
                for (int jj = 1; jj < 8; ++jj) mx = fmaxf(mx, s[jj]);
                const float mnew = fmaxf(mrun, mx);
                if (mnew > -INFINITY) {
                    const float alpha = exp2f(mrun - mnew); lrun *= alpha;
#pragma unroll
                    for (int i = 0; i < 32; ++i) o[i] *= alpha;
#pragma unroll
                    for (int jj = 0; jj < 8; ++jj) { const float p = exp2f(s[jj] - mnew); lrun += p; const float* vr = Vs + (jb * 8 + jj) * 128 + sub * 32;
#pragma unroll
                        for (int i = 0; i < 32; ++i) o[i] += p * vr[i]; }
                    mrun = mnew;
                }
            }
        }
        const float il = 1.f / lrun;
        __syncthreads();
        if (comp == 1) {
#pragma unroll
            for (int i = 0; i < 32; ++i) Ot[row * 128 + sub * 32 + i] = o[i] * il; }
        __syncthreads();
        if (comp == 0) {
            float a1 = 0.f, a2 = 0.f;
            for (int i = 0; i < 64; ++i) { a1 += F.a->in[17][i] * F.a->in[18][i]; a2 += F.a->in[19][i] * F.a->in[20][i]; }
            const float lam = expf(a1) - expf(a2) + LAMBDA_INIT;
            float ss = 0.f;
#pragma unroll
            for (int i = 0; i < 32; ++i) { o[i] = o[i] * il - lam * Ot[row * 128 + sub * 32 + i]; ss += o[i] * o[i]; }
            ss += __shfl_xor(ss, 1); ss += __shfl_xor(ss, 2);
            const float r = (1.0f / sqrtf(ss * (1.f / 128.f) + EPS)) * (1.f - LAMBDA_INIT);
            bf16_t* dst = Y + tq * DM + 512 + h * 128 + sub * 32; const float* sw = F.a->in[21] + sub * 32;
#pragma unroll
            for (int i = 0; i < 32; i += 2) *(unsigned*)(dst + i) = pk2(o[i] * r * sw[i], o[i + 1] * r * sw[i + 1]);
        }
    }
    __syncthreads();
}

namespace dattn {
typedef float f32x16 __attribute__((ext_vector_type(16)));
typedef short s16x4 __attribute__((ext_vector_type(4)));
typedef short v4i16_t __attribute__((ext_vector_type(4)));
#define DA_LAS __attribute__((address_space(3)))
constexpr int SLOT = 32768, K2_OFF = 8192, V_OFF = 16384, STG_PITCH = 132, WSF_OFF = 2 * 128 * STG_PITCH * 4;
__device__ __forceinline__ int crow(int r, int hi) { return (r & 3) + 8 * (r >> 2) + 4 * hi; }
typedef float f32x2_t __attribute__((ext_vector_type(2))); typedef __bf16 bf16x2_t __attribute__((ext_vector_type(2)));
__device__ __forceinline__ unsigned cvtpk(float lo, float hi) { f32x2_t v = {lo, hi}; bf16x2_t b = __builtin_convertvector(v, bf16x2_t); return __builtin_bit_cast(unsigned, b); }
__device__ __forceinline__ s16x4 vtr(const DA_LAS unsigned char* p) { return __builtin_bit_cast(s16x4, __builtin_amdgcn_ds_read_tr16_b64_v4i16((DA_LAS v4i16_t*)p)); }
__device__ __forceinline__ float swap_max(float m) { auto rr = __builtin_amdgcn_permlane32_swap(__float_as_uint(m), __float_as_uint(m), false, false); return fmaxf(__uint_as_float(rr[0]), __uint_as_float(rr[1])); }
__device__ __forceinline__ float swap_sum(float m) { auto rr = __builtin_amdgcn_permlane32_swap(__float_as_uint(m), __float_as_uint(m), false, false); return __uint_as_float(rr[0]) + __uint_as_float(rr[1]); }

template <int THR>
__device__ __forceinline__ void unit(Frame& F, DA_LAS unsigned char* lds, int b, int h, int qb, float lam) {
    const int tid = F.tid, lane = tid & 63, r32 = lane & 31, hi = lane >> 5; const int wid = __builtin_amdgcn_readfirstlane(tid >> 6), comp = wid >> 2, wq = wid & 3;
    const bf16_t* ZX = (const bf16_t*)(F.a->ws + WS_ZX);
    const size_t rowbase = (size_t)b * SEQ; const int q0 = qb * 128, NT = 2 * (qb + 1);
    const bf16_t* k1src = ZX + (rowbase + lane) * NP + CK + h * 128 + wid * 8;
    const bf16_t* vsrc0 = ZX + (rowbase + 16 * ((2 * wid) & 3) + (lane >> 2)) * NP + CV + h * 128 + 32 * ((2 * wid) >> 2) + (lane & 3) * 8;
    const bf16_t* vsrc1 = ZX + (rowbase + 16 * ((2 * wid + 1) & 3) + (lane >> 2)) * NP + CV + h * 128 + 32 * ((2 * wid + 1) >> 2) + (lane & 3) * 8;
#define DA_DMA(t, slot) do { const size_t go_ = (size_t)(t) * 64 * NP; DA_LAS unsigned char* sl_ = lds + (slot) * SLOT; \
        __builtin_amdgcn_global_load_lds((const unsigned*)(k1src + go_), (DA_LAS unsigned*)(sl_ + wid * 1024), 16, 0, 0); \
        __builtin_amdgcn_global_load_lds((const unsigned*)(k1src + go_ + 64), (DA_LAS unsigned*)(sl_ + K2_OFF + wid * 1024), 16, 0, 0); \
        __builtin_amdgcn_global_load_lds((const unsigned*)(vsrc0 + go_), (DA_LAS unsigned*)(sl_ + V_OFF + (2 * wid) * 1024), 16, 0, 0); \
        __builtin_amdgcn_global_load_lds((const unsigned*)(vsrc1 + go_), (DA_LAS unsigned*)(sl_ + V_OFF + (2 * wid + 1) * 1024), 16, 0, 0); } while (0)
    DA_DMA(0, 0);
    const bf16_t* Qw = ZX + (rowbase + q0 + wq * 32 + r32) * NP + CQ + h * 128 + comp * 64 + hi * 8;
    bf16x8 qr[4];
#pragma unroll
    for (int d0 = 0; d0 < 4; ++d0) qr[d0] = *(const bf16x8*)(Qw + d0 * 16);
    float mhat = 0.f, l_reg = 0.f; f32x16 o[4];
#pragma unroll
    for (int d = 0; d < 4; ++d) o[d] = f32x16{};
    DA_LAS float* wsf = (DA_LAS float*)(lds + WSF_OFF) + wid * 64;
    const int qabs = q0 + wq * 32 + r32;
    asm volatile("s_waitcnt vmcnt(0)" ::: "memory"); __syncthreads();
    for (int t = 0; t < NT; ++t) {
        const int cur = t & 1;
        if (t + 1 < NT) DA_DMA(t + 1, cur ^ 1);
        const bool active = (64 * t <= q0 + wq * 32 + 31);
        if (active) {
            const DA_LAS unsigned char* kb = lds + cur * SLOT + (comp ? K2_OFF : 0) + hi * 1024 + r32 * 16;
            f32x16 p0 = f32x16{}, p1 = f32x16{};
#pragma unroll
            for (int d0 = 0; d0 < 4; ++d0) { const bf16x8 k0 = *(const DA_LAS bf16x8*)(kb + d0 * 2048), k1 = *(const DA_LAS bf16x8*)(kb + d0 * 2048 + 512);
                p0 = __builtin_amdgcn_mfma_f32_32x32x16_bf16(k0, qr[d0], p0, 0, 0, 0); p1 = __builtin_amdgcn_mfma_f32_32x32x16_bf16(k1, qr[d0], p1, 0, 0, 0); }
            if (t >= NT - 2) {
#pragma unroll
                for (int r = 0; r < 16; ++r) { const int kv = 64 * t + crow(r, hi); if (kv > qabs) p0[r] = -INFINITY; if (kv + 32 > qabs) p1[r] = -INFINITY; }
            }
            float rm = fmaxf(p0[0], p1[0]);
#pragma unroll
            for (int r = 1; r < 16; ++r) rm = fmaxf(rm, fmaxf(p0[r], p1[r]));
            rm = swap_max(rm);
            if (t == 0) { mhat = rm; }
            else if (__any(rm > mhat + (float)THR)) {
                const float dl = fmaxf(rm - mhat, 0.f); mhat += dl; const float f = __builtin_amdgcn_exp2f(-dl); l_reg *= f;
                if (hi == 0) wsf[r32] = f;
                asm volatile("s_waitcnt lgkmcnt(0)" ::: "memory");
#pragma unroll
                for (int r = 0; r < 16; ++r) { const float fr_ = wsf[crow(r, hi)];
#pragma unroll
                    for (int d = 0; d < 4; ++d) o[d][r] *= fr_; }
            }
            float sacc = 0.f;
#pragma unroll
            for (int r = 0; r < 16; ++r) { p0[r] = __builtin_amdgcn_exp2f(p0[r] - mhat); p1[r] = __builtin_amdgcn_exp2f(p1[r] - mhat); sacc += p0[r] + p1[r]; }
            l_reg += sacc;
            bf16x8 pa[4];
            { unsigned w_[16];
#pragma unroll
              for (int i = 0; i < 8; ++i) { w_[i] = cvtpk(p0[2 * i], p0[2 * i + 1]); w_[8 + i] = cvtpk(p1[2 * i], p1[2 * i + 1]); }
#pragma unroll
              for (int k = 0; k < 4; ++k) { typedef unsigned u32x4_t __attribute__((ext_vector_type(4))); u32x4_t x = {w_[4 * k], w_[4 * k + 1], w_[4 * k + 2], w_[4 * k + 3]}; pa[k] = __builtin_bit_cast(bf16x8, x); } }
            const DA_LAS unsigned char* vb = lds + cur * SLOT + V_OFF + ((lane >> 4) & 1) * 32 + (lane & 3) * 8 + (4 * hi + ((lane & 15) >> 2)) * 64;
#pragma unroll
            for (int d = 0; d < 4; ++d) {
#pragma unroll
                for (int ks = 0; ks < 4; ++ks) { const s16x4 lo = vtr(vb + d * 4096 + ks * 1024), hh = vtr(vb + d * 4096 + ks * 1024 + 512);
                    const bf16x8 vf = (bf16x8){lo[0], lo[1], lo[2], lo[3], hh[0], hh[1], hh[2], hh[3]};
                    o[d] = __builtin_amdgcn_mfma_f32_32x32x16_bf16(pa[ks], vf, o[d], 0, 0, 0); }
            }
        }
        asm volatile("s_waitcnt vmcnt(0) lgkmcnt(0)" ::: "memory"); __syncthreads();
    }
#undef DA_DMA
    l_reg = swap_sum(l_reg);
    if (hi == 0) wsf[32 + r32] = l_reg;
    asm volatile("s_waitcnt lgkmcnt(0)" ::: "memory");
    DA_LAS float* stg = (DA_LAS float*)lds + comp * (128 * STG_PITCH);
#pragma unroll
    for (int r = 0; r < 16; ++r) { const float rl = 1.0f / wsf[32 + crow(r, hi)]; const int row = wq * 32 + crow(r, hi);
#pragma unroll
        for (int d = 0; d < 4; ++d) stg[row * STG_PITCH + d * 32 + r32] = o[d][r] * rl; }
    __syncthreads();
    {
        const int row = tid >> 2, seg = tid & 3; const DA_LAS float* s1 = (const DA_LAS float*)lds + row * STG_PITCH + seg * 32; const DA_LAS float* s2 = s1 + 128 * STG_PITCH;
        float v[32]; float ss = 0.f;
#pragma unroll
        for (int i = 0; i < 32; i += 4) { const f32x4 a = *(const DA_LAS f32x4*)(s1 + i), c = *(const DA_LAS f32x4*)(s2 + i);
            v[i] = a.x - lam * c.x; v[i + 1] = a.y - lam * c.y; v[i + 2] = a.z - lam * c.z; v[i + 3] = a.w - lam * c.w;
            ss += (v[i] * v[i] + v[i + 1] * v[i + 1]) + (v[i + 2] * v[i + 2] + v[i + 3] * v[i + 3]); }
        ss += __shfl_xor(ss, 1); ss += __shfl_xor(ss, 2);
        const float rs = (1.0f / sqrtf(ss * (1.f / 128.f) + EPS)) * (1.f - LAMBDA_INIT);
        const float* sw = F.a->in[21] + seg * 32; bf16_t* dst = (bf16_t*)(F.a->ws + WS_Y) + (rowbase + q0 + row) * DM + 512 + h * 128 + seg * 32;
#pragma unroll
        for (int i = 0; i < 32; i += 8) { uint4 ov; ov.x = pk2(v[i] * rs * sw[i], v[i + 1] * rs * sw[i + 1]); ov.y = pk2(v[i + 2] * rs * sw[i + 2], v[i + 3] * rs * sw[i + 3]);
            ov.z = pk2(v[i + 4] * rs * sw[i + 4], v[i + 5] * rs * sw[i + 5]); ov.w = pk2(v[i + 6] * rs * sw[i + 6], v[i + 7] * rs * sw[i + 7]); *(uint4*)(dst + i) = ov; }
    }
    __syncthreads();
}
}
__device__ __forceinline__ void phase_diff_attn_mfma(Frame& F) {
    float a1 = 0.f, a2 = 0.f;
    for (int i = 0; i < 64; ++i) { a1 += F.a->in[17][i] * F.a->in[18][i]; a2 += F.a->in[19][i] * F.a->in[20][i]; }
    const float lam = expf(a1) - expf(a2) + LAMBDA_INIT;
    const int G = gridDim.x, bx = blockIdx.x; const int vcu = (G % 8 == 0) ? (bx % 8) * (G / 8) + bx / 8 : bx;
    for (int v = vcu; v < 256; v += G) { const int bh = v >> 3, s_ = v & 7;
        dattn::unit<0>(F, (DA_LAS unsigned char*)F.lds, bh >> 2, bh & 3, 15 - s_, lam);
        dattn::unit<0>(F, (DA_LAS unsigned char*)F.lds, bh >> 2, bh & 3, s_, lam); }
}

__device__ __forceinline__ void phase_cross_attn(Frame& F) {
    float* Ks = (float*)F.lds; float* Vs = (float*)(F.lds + 32768);
    const bf16_t* QM = (const bf16_t*)(F.a->ws + WS_QM); const bf16_t* KVM = (const bf16_t*)(F.a->ws + WS_KVM); bf16_t* OM = (bf16_t*)(F.a->ws + WS_OM);
    const int row = F.tid >> 3, sub = F.tid & 7;
    const int NU = BATCH * MH * (SEQ / 64);
    for (int uu = blockIdx.x; uu < NU; uu += gridDim.x) {
        const int qblk = uu & 31, hd = (uu >> 5) & 3, b = uu >> 7; const size_t tq = (size_t)b * SEQ + qblk * 64 + row;
        float q[32], o[32];
#pragma unroll
        for (int i = 0; i < 32; ++i) { q[i] = bf2f(QM[tq * DM + hd * 256 + sub * 32 + i]); o[i] = 0.f; }
        float mrun = -INFINITY, lrun = 0.f;
        for (int kt = 0; kt < 8; ++kt) {
            __syncthreads();
            for (int e = F.tid; e < 8192; e += NTHREADS) { const int j = e >> 8, d = e & 255; const size_t r = ((size_t)b * MEM_LEN + kt * 32 + j) * 2048;
                Ks[e] = bf2f(KVM[r + hd * 256 + d]); Vs[e] = bf2f(KVM[r + 1024 + hd * 256 + d]); }
            __syncthreads();
            _Pragma("unroll 1") for (int jb = 0; jb < 4; ++jb) {
                float s[8];
#pragma unroll
                for (int jj = 0; jj < 8; ++jj) { const float* kr = Ks + (jb * 8 + jj) * 256 + sub * 32; float a = 0.f;
#pragma unroll
                    for (int i = 0; i < 32; ++i) a += q[i] * kr[i];
                    a += __shfl_xor(a, 1); a += __shfl_xor(a, 2); a += __shfl_xor(a, 4); s[jj] = a; }
                float mx = s[0];
#pragma unroll
                for (int jj = 1; jj < 8; ++jj) mx = fmaxf(mx, s[jj]);
                const float mnew = fmaxf(mrun, mx); const float alpha = exp2f(mrun - mnew); lrun *= alpha;
#pragma unroll
                for (int i = 0; i < 32; ++i) o[i] *= alpha;
#pragma unroll
                for (int jj = 0; jj < 8; ++jj) { const float p = exp2f(s[jj] - mnew); lrun += p; const float* vr = Vs + (jb * 8 + jj) * 256 + sub * 32;
#pragma unroll
                    for (int i = 0; i < 32; ++i) o[i] += p * vr[i]; }
                mrun = mnew;
            }
        }
        const float il = 1.f / lrun; bf16_t* dst = OM + tq * DM + hd * 256 + sub * 32;
#pragma unroll
        for (int i = 0; i < 32; i += 2) *(unsigned*)(dst + i) = pk2(o[i] * il, o[i + 1] * il);
    }
    __syncthreads();
}

__device__ __forceinline__ void phase_resid_norm(Frame& F, const float* T, const float* base, const float* g_post, float* xo, const float* g_next, bf16_t* XN) {
    for (int m = F.gw; m < M; m += F.ngw) {
        const f32x4* tr = (const f32x4*)(T + (size_t)m * DM) + F.lane; const f32x4* br = (const f32x4*)(base + (size_t)m * DM) + F.lane;
        f32x4 v[4]; float s = 0.f;
#pragma unroll
        for (int j = 0; j < 4; ++j) { v[j] = tr[64 * j]; s += (v[j].x * v[j].x + v[j].y * v[j].y) + (v[j].z * v[j].z + v[j].w * v[j].w); }
        const float r = 1.0f / sqrtf(wave_sum(s) * (1.f / DM) + EPS); float s2 = 0.f;
#pragma unroll
        for (int j = 0; j < 4; ++j) { const f32x4 g = *((const f32x4*)g_post + F.lane + 64 * j); v[j] = br[64 * j] + v[j] * r * g; *((f32x4*)(xo + (size_t)m * DM) + F.lane + 64 * j) = v[j];
            s2 += (v[j].x * v[j].x + v[j].y * v[j].y) + (v[j].z * v[j].z + v[j].w * v[j].w); }
        if (XN) { const float r2 = 1.0f / sqrtf(wave_sum(s2) * (1.f / DM) + EPS);
#pragma unroll
            for (int j = 0; j < 4; ++j) { const f32x4 g = *((const f32x4*)g_next + F.lane + 64 * j); const f32x4 w = v[j] * r2 * g; uint2 o; o.x = pk2(w.x, w.y); o.y = pk2(w.z, w.w); *((uint2*)(XN + (size_t)m * DM) + F.lane + 64 * j) = o; } }
    }
}

constexpr int NPHASE = 16;
__global__ void __launch_bounds__(NTHREADS, 2) mk_fwd(Args args) {
    extern __shared__ __attribute__((aligned(16))) unsigned char lds[];
    Frame F; F.lds = lds; F.tid = threadIdx.x; F.lane = F.tid & 63; F.wave = F.tid >> 6; F.gw = blockIdx.x * 8 + F.wave; F.ngw = gridDim.x * 8; F.a = &args;
    unsigned char* ws = args.ws;
    bf16_t* XN = (bf16_t*)(ws + WS_XN);
    const int lo = args.ph_lo, hi = args.ph_hi;
#ifdef ONLY
#define IN(k) ((k) == ONLY && lo <= (k) && (k) < hi)
#elif defined(PMASK)
#define IN(k) (((PMASK >> (k)) & 1) && lo <= (k) && (k) < hi)
#else
#define IN(k) (lo <= (k) && (k) < hi)
#endif
#if MK_SINGLE
#define SEAM(k) do { if ((k) + 1 < hi) cg::this_grid().sync(); } while (0)
#else
#define SEAM(k) do { } while (0)
#endif
#define PG8_RUN(Aptr, Btptr, Mr, Nc, Kk, EPI) do { pg8::Gemm g_{(const bf16_t*)(Aptr), (const bf16_t*)(Btptr), (Mr), (Nc), (Kk)}; pg8::StaticOrder S_; S_.init((Mr), (Nc), (int)gridDim.x, (int)blockIdx.x); \
        auto e_ = (EPI); pg8::EpiGen<decltype(e_)> E_{e_}; pg8::gemm_phase<pg8::EpiGen<decltype(e_)>, pg8::StaticOrder, PG8_ALIGN, PG8_SP2>((PG8_LAS unsigned char*)lds, g_, S_, E_); } while (0)
    if (IN(0)) { phase_prologue(F); SEAM(0); }
    if (IN(1)) { PG8_RUN(XN, ws + WS_WIN, M, NP, DM, (EpiBf16{(bf16_t*)(ws + WS_ZX), NP, 1.f}));
                 PG8_RUN(ws + WS_MEMH, ws + WS_WMKV, MM, 2048, DM, (EpiBf16{(bf16_t*)(ws + WS_KVM), 2048, 1.f})); SEAM(1); }
    if (IN(2)) { phase_rope(F); SEAM(2); }
    if (IN(3)) { phase_ssd_states(F); SEAM(3); }
    if (IN(4)) { phase_ssd_y(F); SEAM(4); }
    if (IN(5)) { phase_ssd_norm(F); SEAM(5); }
    if (IN(6)) { phase_diff_attn_mfma(F); SEAM(6); }
    if (IN(7)) { PG8_RUN(ws + WS_Y, ws + WS_WOUT, M, DM, DM, (EpiF32{(float*)(ws + WS_T), DM})); SEAM(7); }
    if (IN(8)) { phase_resid_norm(F, (const float*)(ws + WS_T), args.in[0], args.in[4], args.out, args.in[5], XN); SEAM(8); }
    if (IN(9)) { PG8_RUN(XN, ws + WS_WMQ, M, DM, DM, (EpiBf16{(bf16_t*)(ws + WS_QM), DM, C2_MEM})); SEAM(9); }
    if (IN(10)) { phase_cross_attn(F); SEAM(10); }
    if (IN(11)) { PG8_RUN(ws + WS_OM, ws + WS_WMO, M, DM, DM, (EpiF32{(float*)(ws + WS_T), DM})); SEAM(11); }
    if (IN(12)) { phase_resid_norm(F, (const float*)(ws + WS_T), args.out, args.in[7], args.out, args.in[8], XN); SEAM(12); }
    if (IN(13)) { PG8_RUN(XN, ws + WS_WUP, M, DFF, DM, (EpiRelu2{(bf16_t*)(ws + WS_H), DFF})); SEAM(13); }
    if (IN(14)) { PG8_RUN(ws + WS_H, ws + WS_WDN, M, DM, DFF, (EpiF32{(float*)(ws + WS_T2), DM})); SEAM(14); }
    if (IN(15)) { phase_resid_norm(F, (const float*)(ws + WS_T2), args.out, args.in[9], args.out, nullptr, nullptr); }
#undef IN
#undef SEAM
}

extern "C" void kernel_launch(void* const* d_in, const int* in_sizes, int n_in, void* d_out, int out_size, void* d_ws, size_t ws_size, hipStream_t stream) {
    static int grid = 0;
    if (grid == 0) {
        if (n_in != 29 || out_size != M * DM || ws_size < WS_END) { fprintf(stderr, "kernel_launch: unexpected shapes n_in %d out %d ws %zu\n", n_in, out_size, ws_size); grid = -1; return; }
        int dev = 0, cus = 0, per_cu = 0;
        hipGetDevice(&dev); hipDeviceGetAttribute(&cus, hipDeviceAttributeMultiprocessorCount, dev);
        hipFuncSetAttribute((const void*)mk_fwd, hipFuncAttributeMaxDynamicSharedMemorySize, LDS_BYTES);
        hipOccupancyMaxActiveBlocksPerMultiprocessor(&per_cu, (const void*)mk_fwd, NTHREADS, LDS_BYTES);
        if (per_cu < 1) per_cu = 1;
        grid = cus * per_cu;
        fprintf(stderr, "kernel_launch: cus %d per_cu %d grid %d\n", cus, per_cu, grid);
    }
    if (grid < 0) return;
    Args a{};
    for (int i = 0; i < 29; ++i) a.in[i] = (const float*)d_in[i];
    a.out = (float*)d_out; a.ws = (unsigned char*)d_ws;
#if MK_SINGLE
    a.ph_lo = 0; a.ph_hi = NPHASE; a.coop = 1;
    void* kargs[] = {&a};
    hipError_t e = hipLaunchCooperativeKernel((const void*)mk_fwd, dim3(grid), dim3(NTHREADS), kargs, LDS_BYTES, stream);
    if (e != hipSuccess) fprintf(stderr, "cooperative launch failed: %s (grid %d)\n", hipGetErrorString(e), grid);
#else
    for (int ph = 0; ph < NPHASE; ++ph) { a.ph_lo = ph; a.ph_hi = ph + 1; a.coop = 0; hipLaunchKernelGGL(mk_fwd, dim3(grid), dim3(NTHREADS), LDS_BYTES, stream, a); }
#endif
}
```

```cpp
#include <hip/hip_runtime.h>
#include <hip/hip_cooperative_groups.h>
#include <cstdio>
#include <cstdint>
namespace cg = cooperative_groups;

#ifndef MK_SINGLE
#define MK_SINGLE 1
#endif

constexpr int BATCH = 8, SEQ = 2048, DM = 1024, M = BATCH * SEQ, MEM_LEN = 256, MM = BATCH * MEM_LEN;
constexpr int D_SSD = 512, SSD_HD = 64, SSD_H = 8, SSD_N = 128, CHUNK = 128, NCH = SEQ / CHUNK;
constexpr int D_IN = 3080, NP = 3072;
constexpr int CZ = 0, CXBC = 512, CQ = 1536, CK = 2048, CV = 2560;
constexpr int DH = 4;
constexpr int MH = 4, MHD = 256, DFF = 4096;
constexpr float EPS = 1e-6f;
constexpr float LOG2E = 1.4426950408889634f;
constexpr float C2_DIFF = 0.125f * LOG2E;
constexpr float C2_MEM = 0.0625f * LOG2E;
constexpr float LAMBDA_INIT = 0.2f;

constexpr size_t MiB = 1u << 20;
constexpr size_t WS_WIN = 2 * MiB, WS_WOUT = 8 * MiB, WS_WMQ = 10 * MiB, WS_WMKV = 12 * MiB, WS_WMO = 16 * MiB, WS_WUP = 18 * MiB, WS_WDN = 26 * MiB;
constexpr size_t WS_DT = 37 * MiB, WS_SSQ = 37 * MiB + 512 * 1024, WS_COS = 38 * MiB, WS_SIN = 40 * MiB;
constexpr size_t WS_MEMH = 42 * MiB, WS_KVM = 46 * MiB, WS_ST = 54 * MiB, WS_DEC = 86 * MiB, WS_XN = 88 * MiB;
constexpr size_t WS_ZX = 128 * MiB, WS_Y = 224 * MiB, WS_T = 128 * MiB, WS_QM = 192 * MiB, WS_OM = 224 * MiB, WS_H = 128 * MiB, WS_T2 = 56 * MiB;
constexpr size_t WS_XC = 88 * MiB, WS_DTL = 120 * MiB, WS_CUM = 120 * MiB + 512 * 1024;
constexpr size_t WS_END = 256 * MiB;

constexpr int LDS_BYTES = 148480, MISC_OFF = 147456;
constexpr size_t WS_CTL = 0, CTL_ZERO_BYTES = 65536;
constexpr int NTHREADS = 512;

typedef unsigned short bf16_t;
typedef short bf16x8 __attribute__((ext_vector_type(8)));
typedef float f32x4 __attribute__((ext_vector_type(4)));
typedef unsigned u32x4_t __attribute__((ext_vector_type(4)));
typedef unsigned u32x2_t __attribute__((ext_vector_type(2)));

__device__ __forceinline__ float bf2f(bf16_t v) { return __uint_as_float(((unsigned)v) << 16); }
__device__ __forceinline__ bf16_t f2bf(float f) { unsigned u = __float_as_uint(f); return (bf16_t)((u + 0x7fffu + ((u >> 16) & 1u)) >> 16); }
__device__ __forceinline__ unsigned pk2(float lo, float hi) { return (unsigned)f2bf(lo) | ((unsigned)f2bf(hi) << 16); }
__device__ __forceinline__ float wave_sum(float v) {
#pragma unroll
    for (int o = 1; o < 64; o <<= 1) v += __shfl_xor(v, o);
    return v;
}
__device__ __forceinline__ float silu_f(float x) { return x / (1.f + expf(-x)); }
__device__ __forceinline__ float softplus_f(float x) { return x > 20.f ? x : log1pf(expf(x)); }

struct Args {
    const float* in[29];
    float* out;
    unsigned char* ws;
    int ph_lo, ph_hi, coop, pad;
};

struct Frame {
    unsigned char* lds;
    int tid, lane, wave, gw, ngw;
    const Args* a;
};

__device__ __forceinline__ void transpose_item(const float* W, int ldw, int src_col0, int K, bf16_t* WT, int n0, int k0, float* scr, int lane) {
#pragma unroll 8
    for (int i = 0; i < 32; ++i) { const int kk = 2 * i + (lane >> 5); scr[kk * 33 + (lane & 31)] = W[(size_t)(k0 + kk) * ldw + src_col0 + n0 + (lane & 31)]; }
    __builtin_amdgcn_wave_barrier();
    asm volatile("s_waitcnt lgkmcnt(0)" ::: "memory");
    const int c = lane & 7;
#pragma unroll
    for (int j = 0; j < 4; ++j) { const int n = (lane >> 3) + 8 * j; const float* s = scr + (8 * c) * 33 + n;
        uint4 o; o.x = pk2(s[0 * 33], s[1 * 33]); o.y = pk2(s[2 * 33], s[3 * 33]); o.z = pk2(s[4 * 33], s[5 * 33]); o.w = pk2(s[6 * 33], s[7 * 33]);
        *(uint4*)(WT + (size_t)(n0 + n) * K + k0 + 8 * c) = o; }
    asm volatile("s_waitcnt lgkmcnt(0)" ::: "memory");
    __builtin_amdgcn_wave_barrier();
}

__device__ __forceinline__ void rms_row(const float* xrow, const float* g, bf16_t* orow, int lane, f32x4 (&v)[4]) {
    const f32x4* xr = (const f32x4*)xrow + lane; const f32x4* gr = (const f32x4*)g + lane;
    float s = 0.f;
#pragma unroll
    for (int j = 0; j < 4; ++j) { v[j] = xr[64 * j]; s += (v[j].x * v[j].x + v[j].y * v[j].y) + (v[j].z * v[j].z + v[j].w * v[j].w); }
    const float r = 1.0f / sqrtf(wave_sum(s) * (1.f / DM) + EPS);
#pragma unroll
    for (int j = 0; j < 4; ++j) { const f32x4 gg = gr[64 * j]; v[j] = v[j] * r * gg;
        uint2 o; o.x = pk2(v[j].x, v[j].y); o.y = pk2(v[j].z, v[j].w); *((uint2*)orow + lane + 64 * j) = o; }
}

__device__ __forceinline__ void phase_prologue(Frame& F) {
    const Args& A = *F.a; unsigned char* ws = A.ws;
    float* scr = (float*)(F.lds + F.wave * 8704);
    float* dtw = (float*)(F.lds + 73728);
    for (int e = F.tid; e < 1024 * 8; e += NTHREADS) dtw[e] = A.in[10][(size_t)(e >> 3) * D_IN + 1536 + (e & 7)];
    constexpr int I_IN = 16 * 96, I_SQ = 16 * 32, I_UP = 16 * 128, I_DN = 64 * 32;
    constexpr int NITEMS = I_IN + 5 * I_SQ + I_UP + I_DN;
    for (int it = F.gw; it < NITEMS; it += F.ngw) {
        int r = it;
        if (r < I_IN) { const int nb = r % 96, kb = r / 96; const int n0 = nb * 32; transpose_item(A.in[10], D_IN, n0 >= 1536 ? 8 : 0, 1024, (bf16_t*)(ws + WS_WIN), n0, kb * 64, scr, F.lane); continue; } r -= I_IN;
        if (r < I_SQ) { transpose_item(A.in[22], 1024, 0, 1024, (bf16_t*)(ws + WS_WOUT), (r % 32) * 32, (r / 32) * 64, scr, F.lane); continue; } r -= I_SQ;
        if (r < I_SQ) { transpose_item(A.in[23], 1024, 0, 1024, (bf16_t*)(ws + WS_WMQ), (r % 32) * 32, (r / 32) * 64, scr, F.lane); continue; } r -= I_SQ;
        if (r < I_SQ) { transpose_item(A.in[24], 1024, 0, 1024, (bf16_t*)(ws + WS_WMKV), (r % 32) * 32, (r / 32) * 64, scr, F.lane); continue; } r -= I_SQ;
        if (r < I_SQ) { transpose_item(A.in[25], 1024, 0, 1024, (bf16_t*)(ws + WS_WMKV) + (size_t)1024 * 1024, (r % 32) * 32, (r / 32) * 64, scr, F.lane); continue; } r -= I_SQ;
        if (r < I_SQ) { transpose_item(A.in[26], 1024, 0, 1024, (bf16_t*)(ws + WS_WMO), (r % 32) * 32, (r / 32) * 64, scr, F.lane); continue; } r -= I_SQ;
        if (r < I_UP) { transpose_item(A.in[27], 4096, 0, 1024, (bf16_t*)(ws + WS_WUP), (r % 128) * 32, (r / 128) * 64, scr, F.lane); continue; } r -= I_UP;
        transpose_item(A.in[28], 1024, 0, 4096, (bf16_t*)(ws + WS_WDN), (r % 32) * 32, (r / 32) * 64, scr, F.lane);
    }
    __syncthreads();
    for (int m = F.gw; m < M; m += F.ngw) {
        f32x4 v[4];
        rms_row(A.in[0] + (size_t)m * DM, A.in[3], (bf16_t*)(ws + WS_XN) + (size_t)m * DM, F.lane, v);
        float acc[8];
#pragma unroll
        for (int h = 0; h < 8; ++h) acc[h] = 0.f;
#pragma unroll 1
        for (int j = 0; j < 4; ++j)
#pragma unroll
            for (int e = 0; e < 4; ++e) { const int k = 256 * j + 4 * F.lane + e; const f32x4 w0 = *(const f32x4*)(dtw + k * 8), w1 = *(const f32x4*)(dtw + k * 8 + 4); const float hv = v[j][e];
                acc[0] += hv * w0.x; acc[1] += hv * w0.y; acc[2] += hv * w0.z; acc[3] += hv * w0.w; acc[4] += hv * w1.x; acc[5] += hv * w1.y; acc[6] += hv * w1.z; acc[7] += hv * w1.w; }
#pragma unroll
        for (int h = 0; h < 8; ++h) acc[h] = wave_sum(acc[h]);
        if (F.lane == 0) { float* d = (float*)(ws + WS_DT) + (size_t)m * 8;
#pragma unroll
            for (int h = 0; h < 8; ++h) d[h] = acc[h]; }
    }
    for (int m = F.gw; m < MM; m += F.ngw) { f32x4 v[4]; rms_row(A.in[1] + (size_t)m * DM, A.in[6], (bf16_t*)(ws + WS_MEMH) + (size_t)m * DM, F.lane, v); }
    { const int gt = blockIdx.x * NTHREADS + F.tid, ngt = gridDim.x * NTHREADS; const int* pos = (const int*)A.in[2];
      float* C = (float*)(ws + WS_COS); float* S = (float*)(ws + WS_SIN);
      for (int e = gt; e < M * 32; e += ngt) { const int t = e >> 5, i = e & 31; const float inv = powf(10000.f, -(float)i / 32.f); const float ang = (float)pos[t] * inv; float sn, cs; sincosf(ang, &sn, &cs); C[e] = cs; S[e] = sn; } }
}

struct EpiBf16 { bf16_t* O; int ldc; float scale;
    __device__ __forceinline__ void operator()(int row, int col, f32x4 v) const { uint2 o; o.x = pk2(v.x * scale, v.y * scale); o.y = pk2(v.z * scale, v.w * scale); *(uint2*)(O + (size_t)row * ldc + col) = o; } };
struct EpiF32 { float* O; int ldc;
    __device__ __forceinline__ void operator()(int row, int col, f32x4 v) const { *(f32x4*)(O + (size_t)row * ldc + col) = v; } };
struct EpiRelu2 { bf16_t* O; int ldc;
    __device__ __forceinline__ void operator()(int row, int col, f32x4 v) const { float a = fmaxf(v.x, 0.f), b = fmaxf(v.y, 0.f), c = fmaxf(v.z, 0.f), d = fmaxf(v.w, 0.f);
        uint2 o; o.x = pk2(a * a, b * b); o.y = pk2(c * c, d * d); *(uint2*)(O + (size_t)row * ldc + col) = o; } };

template <class Epi>
__device__ __forceinline__ void gemm_simple(Frame& F, const bf16_t* A, int lda, const bf16_t* Bt, int ldb, int Mr, int Nc, int K, const Epi& E) {
    bf16_t* As = (bf16_t*)F.lds; bf16_t* Bs = As + 128 * 40;
    const int tid = F.tid, lane = F.lane, wid = F.wave, wr = wid >> 2, wc = wid & 3, fr = lane & 15, fq = lane >> 4;
    const int ntn = Nc / 128, ntiles = (Mr / 128) * ntn;
    for (int u = blockIdx.x; u < ntiles; u += gridDim.x) {
        const int tm = u / ntn, tn = u % ntn;
        f32x4 acc[4][2];
#pragma unroll
        for (int m = 0; m < 4; ++m)
#pragma unroll
            for (int n = 0; n < 2; ++n) acc[m][n] = (f32x4){0.f, 0.f, 0.f, 0.f};
        const bf16_t* Ag = A + (size_t)(tm * 128 + (tid >> 2)) * lda + (tid & 3) * 8;
        const bf16_t* Bg = Bt + (size_t)(tn * 128 + (tid >> 2)) * ldb + (tid & 3) * 8;
        for (int k0 = 0; k0 < K; k0 += 32) {
            const uint4 va = *(const uint4*)(Ag + k0), vb = *(const uint4*)(Bg + k0);
            __syncthreads();
            *(uint4*)(As + (tid >> 2) * 40 + (tid & 3) * 8) = va;
            *(uint4*)(Bs + (tid >> 2) * 40 + (tid & 3) * 8) = vb;
            __syncthreads();
            bf16x8 af[4], bfr[2];
#pragma unroll
            for (int m = 0; m < 4; ++m) af[m] = *(const bf16x8*)(As + (wr * 64 + m * 16 + fr) * 40 + fq * 8);
#pragma unroll
            for (int n = 0; n < 2; ++n) bfr[n] = *(const bf16x8*)(Bs + (wc * 32 + n * 16 + fr) * 40 + fq * 8);
#pragma unroll
            for (int m = 0; m < 4; ++m)
#pragma unroll
                for (int n = 0; n < 2; ++n) acc[m][n] = __builtin_amdgcn_mfma_f32_16x16x32_bf16(bfr[n], af[m], acc[m][n], 0, 0, 0);
        }
#pragma unroll
        for (int m = 0; m < 4; ++m)
#pragma unroll
            for (int n = 0; n < 2; ++n) E(tm * 128 + wr * 64 + m * 16 + fr, tn * 128 + wc * 32 + n * 16 + fq * 4, acc[m][n]);
    }
    __syncthreads();
}

namespace pg8 {
#define PG8_LAS __attribute__((address_space(3)))
typedef unsigned short bf16_t;
typedef short bf16x8 __attribute__((ext_vector_type(8)));
typedef float f32x4 __attribute__((ext_vector_type(4)));
typedef unsigned u32x4 __attribute__((ext_vector_type(4)));
constexpr int BM = 256, BK = 64, HALF = 128, HTB = HALF * BK * 2  , STAGE_BYTES = 8 * HTB, NXCD = 8, WGM = 8;

__host__ __device__ __forceinline__ int lds_byte(int r, int c) { const int st = (r >> 4) * 2 + (c >> 5), rr = r & 15, cc = c & 31, ob = rr * 64 + cc * 2; return st * 1024 + (ob ^ (((ob >> 9) & 1) << 5)); }
__host__ __device__ __forceinline__ void stage_rc(int b, int& R, int& C) { const int st = b / 1024, sb = b % 1024, swz = sb ^ (((sb >> 9) & 1) << 5); R = (st >> 1) * 16 + swz / 64; C = (st & 1) * 32 + (swz % 64) / 2; }
__host__ __device__ __forceinline__ int perm32(int rho) { const int n = rho >> 4, i = rho & 15; return 8 * (i >> 2) + 4 * n + (i & 3); }

struct Unit { int pm, pn; };
struct Gemm { const bf16_t* A; const bf16_t* Bt; int M, N, K; };

struct StaticOrder {
    int nM, nN, nwg, G, c;
    __host__ __device__ void init(int M, int N, int G_, int c_) { nM = M / BM; nN = N / BM; nwg = nM * nN; G = G_; c = c_; }
    __host__ __device__ bool next(int i, Unit& u) const {
        const long L = (long)i * G + c; if (L >= nwg) return false;
        int wgid = (int)L; { const int q = nwg / NXCD, r = nwg % NXCD, xcd = wgid % NXCD, off = wgid / NXCD; wgid = (xcd < r ? xcd * (q + 1) : r * (q + 1) + (xcd - r) * q) + off; }
        const int nig = WGM * nN, gid = wgid / nig, fm = gid * WGM, gsz = (nM - fm) < WGM ? (nM - fm) : WGM;
        u.pm = fm + ((wgid % nig) % gsz); u.pn = (wgid % nig) / gsz; return true;
    }
    __device__ __forceinline__ void a_ready(const Unit&) const {}
    __device__ __forceinline__ void done(const Unit&) const {}
};
__device__ __forceinline__ unsigned cvt_pk_bf16(float lo, float hi) { unsigned r; asm volatile("v_cvt_pk_bf16_f32 %0, %1, %2" : "=v"(r) : "v"(lo), "v"(hi)); return r; }
typedef float f32x2 __attribute__((ext_vector_type(2)));

template <class Fn> struct EpiGen {
    static constexpr bool PERM = false, AFTER_DRAIN = false; Fn fn;
    __device__ __forceinline__ void operator()(const f32x4 (&acc)[2][2][4][2], const Unit& u, int wr, int wc, int fr, int fq) const {
#pragma unroll
        for (int ai = 0; ai < 2; ++ai)
#pragma unroll
            for (int m = 0; m < 4; ++m)
#pragma unroll
                for (int bj = 0; bj < 2; ++bj)
#pragma unroll
                    for (int n = 0; n < 2; ++n) fn(u.pm * BM + ai * HALF + wr * 64 + m * 16 + fr, u.pn * BM + bj * HALF + wc * 32 + n * 16 + fq * 4, acc[ai][bj][m][n]);
    }
};
template <class Epi, class Sched, bool ALIGN_EPI = false, bool SP2 = false>
__device__ __forceinline__ void gemm_phase(PG8_LAS unsigned char* lds, const Gemm g, const Sched& S, const Epi& E) {
    const int tid = threadIdx.x, wid = __builtin_amdgcn_readfirstlane(tid >> 6), lane = tid & 63, wr = wid >> 2, wc = wid & 3, fr = lane & 15, fq = lane >> 4;
    const int K = g.K, nt = K / BK;
    unsigned voffA[2], voffB[2];
#pragma unroll
    for (int i = 0; i < 2; ++i) { int R, C; stage_rc(tid * 16 + i * 8192, R, C); const int Rb = Epi::PERM ? ((R & ~31) + perm32(R & 31)) : R;
        voffA[i] = (unsigned)(R * K + C) * 2u; voffB[i] = (unsigned)(Rb * K + C) * 2u; }
    const size_t kstep = (size_t)(BK * 2);
    const size_t hstep = (size_t)HALF * K * 2;
    const size_t tstep = 2 * hstep;
    const unsigned ldsw = (unsigned)wid * 1024u;
    const int aoff = lds_byte(wr * 64 + fr, fq * 8), boff = lds_byte(wc * 32 + fr, fq * 8);
#define PG8_SA(b, h) (((b) * 2 + (h)) * HTB)
#define PG8_SB(b, h) ((4 + (b) * 2 + (h)) * HTB)
#define PG8_STAGE(bufoff, gbase, voff) do { _Pragma("unroll") for (int _i = 0; _i < 2; ++_i) \
        __builtin_amdgcn_global_load_lds((const unsigned*)((const char*)(gbase) + (voff)[_i]), (PG8_LAS unsigned*)(lds + (bufoff) + ldsw + _i * 8192), 16, 0, 0); } while (0)
#define PG8_LDA(dst, b, h) do { _Pragma("unroll") for (int m = 0; m < 4; ++m) _Pragma("unroll") for (int k = 0; k < 2; ++k) dst[m][k] = *(const PG8_LAS bf16x8*)(lds + PG8_SA(b, h) + aoff + m * 2048 + k * 1024); } while (0)
#define PG8_LDB(dst, b, h) do { _Pragma("unroll") for (int n = 0; n < 2; ++n) _Pragma("unroll") for (int k = 0; k < 2; ++k) dst[n][k] = *(const PG8_LAS bf16x8*)(lds + PG8_SB(b, h) + boff + n * 2048 + k * 1024); } while (0)
#define PG8_MMA(ai, bj, At, Bt) do { __builtin_amdgcn_s_setprio(1); _Pragma("unroll") for (int m = 0; m < 4; ++m) _Pragma("unroll") for (int n = 0; n < 2; ++n) _Pragma("unroll") for (int k = 0; k < 2; ++k) \
        acc[ai][bj][m][n] = __builtin_amdgcn_mfma_f32_16x16x32_bf16(Bt[n][k], At[m][k], acc[ai][bj][m][n], 0, 0, 0); __builtin_amdgcn_s_setprio(0); } while (0)
#define PG8_WAIT_V(n) asm volatile("s_waitcnt vmcnt(" #n ")" ::: "memory")
#define PG8_WAIT_L(n) asm volatile("s_waitcnt lgkmcnt(" #n ")" ::: "memory")
#define PG8_BAR __builtin_amdgcn_s_barrier()
#define PG8_SCHED __builtin_amdgcn_sched_barrier(0)
    Unit cur, nxt; int ui = 0;
    if (!S.next(0, cur)) return;
    f32x4 acc[2][2][4][2];
#pragma unroll
    for (int a = 0; a < 2; ++a)
#pragma unroll
        for (int b = 0; b < 2; ++b)
#pragma unroll
            for (int m = 0; m < 4; ++m)
#pragma unroll
                for (int n = 0; n < 2; ++n) acc[a][b][m][n] = (f32x4){0.f, 0.f, 0.f, 0.f};
    bf16x8 At[4][2], B0[2][2], B1[2][2];
    const char* cA = (const char*)g.A + (size_t)cur.pm * tstep; const char* cB = (const char*)g.Bt + (size_t)cur.pn * tstep;
    S.a_ready(cur);
    if constexpr (SP2) {
        PG8_STAGE(PG8_SB(0, 0), cB, voffB); PG8_STAGE(PG8_SB(0, 1), cB + hstep, voffB); PG8_STAGE(PG8_SA(0, 0), cA, voffA); PG8_STAGE(PG8_SA(0, 1), cA + hstep, voffA);
        if (wr == 1) PG8_BAR;
        PG8_WAIT_V(2); PG8_BAR;
        PG8_STAGE(PG8_SB(1, 0), cB + kstep, voffB); PG8_STAGE(PG8_SA(1, 0), cA + kstep, voffA); PG8_STAGE(PG8_SB(1, 1), cB + hstep + kstep, voffB);
        PG8_WAIT_V(6); PG8_BAR;
    } else {
        PG8_STAGE(PG8_SB(0, 0), cB, voffB); PG8_STAGE(PG8_SA(0, 0), cA, voffA); PG8_STAGE(PG8_SB(0, 1), cB + hstep, voffB); PG8_STAGE(PG8_SA(0, 1), cA + hstep, voffA);
        if (wr == 1) PG8_BAR;
        PG8_WAIT_V(4); PG8_BAR;
        PG8_STAGE(PG8_SB(1, 0), cB + kstep, voffB); PG8_STAGE(PG8_SA(1, 0), cA + kstep, voffA); PG8_STAGE(PG8_SB(1, 1), cB + hstep + kstep, voffB);
        PG8_WAIT_V(6); PG8_BAR;
    }
    for (;;) {
        const bool has_next = S.next(ui + 1, nxt);
        const char* nA = has_next ? (const char*)g.A + (size_t)nxt.pm * tstep : cA; const char* nB = has_next ? (const char*)g.Bt + (size_t)nxt.pn * tstep : cB;
        for (int t = 0; t < nt; t += 2) {
            const bool last = (t == nt - 2);
            const char* a1 = cA + (size_t)(t + 1) * kstep;
            const char* a2 = last ? nA : cA + (size_t)(t + 2) * kstep; const char* b2 = last ? nB : cB + (size_t)(t + 2) * kstep;
            const char* a3 = a2 + kstep; const char* b3 = b2 + kstep;
            if (last && has_next) S.a_ready(nxt);
            if constexpr (SP2) {
            PG8_LDB(B0, 0, 0); PG8_LDB(B1, 0, 1); PG8_SCHED; PG8_LDA(At, 0, 0); PG8_STAGE(PG8_SA(1, 1), a1 + hstep, voffA);
            PG8_WAIT_V(8); PG8_WAIT_L(0); PG8_BAR; PG8_MMA(0, 0, At, B0); PG8_MMA(0, 1, At, B1); PG8_BAR; PG8_SCHED;
            PG8_LDA(At, 0, 1); PG8_STAGE(PG8_SB(0, 0), b2, voffB); PG8_STAGE(PG8_SB(0, 1), b2 + hstep, voffB); PG8_STAGE(PG8_SA(0, 0), a2, voffA);
            PG8_WAIT_V(8); PG8_WAIT_L(0); PG8_BAR; PG8_MMA(1, 0, At, B0); PG8_MMA(1, 1, At, B1); PG8_BAR; PG8_SCHED;
            PG8_LDB(B0, 1, 0); PG8_LDB(B1, 1, 1); PG8_SCHED; PG8_LDA(At, 1, 0); PG8_STAGE(PG8_SA(0, 1), a2 + hstep, voffA);
            PG8_WAIT_V(8); PG8_WAIT_L(0); PG8_BAR; PG8_MMA(0, 0, At, B0); PG8_MMA(0, 1, At, B1); PG8_BAR; PG8_SCHED;
            PG8_LDA(At, 1, 1); PG8_STAGE(PG8_SB(1, 0), b3, voffB); PG8_STAGE(PG8_SB(1, 1), b3 + hstep, voffB); PG8_STAGE(PG8_SA(1, 0), a3, voffA);
            PG8_WAIT_V(8); PG8_WAIT_L(0); PG8_BAR; PG8_MMA(1, 0, At, B0); PG8_MMA(1, 1, At, B1); PG8_BAR; PG8_SCHED;
            } else {
            PG8_LDB(B0, 0, 0); PG8_SCHED; PG8_LDA(At, 0, 0); PG8_STAGE(PG8_SA(1, 1), a1 + hstep, voffA);
            PG8_WAIT_L(8); PG8_BAR; PG8_WAIT_L(0); PG8_MMA(0, 0, At, B0); PG8_BAR; PG8_SCHED;
            PG8_LDB(B1, 0, 1); PG8_STAGE(PG8_SB(0, 0), b2, voffB);
            PG8_BAR; PG8_WAIT_L(0); PG8_MMA(0, 1, At, B1); PG8_BAR;
            PG8_LDA(At, 0, 1); PG8_STAGE(PG8_SA(0, 0), a2, voffA);
            PG8_BAR; PG8_WAIT_L(0); PG8_MMA(1, 0, At, B0); PG8_BAR; PG8_SCHED;
            PG8_STAGE(PG8_SB(0, 1), b2 + hstep, voffB);
            PG8_WAIT_V(6); PG8_BAR; PG8_MMA(1, 1, At, B1); PG8_BAR;
            PG8_LDB(B0, 1, 0); PG8_SCHED; PG8_LDA(At, 1, 0); PG8_STAGE(PG8_SA(0, 1), a2 + hstep, voffA);
            PG8_WAIT_L(8); PG8_BAR; PG8_WAIT_L(0); PG8_MMA(0, 0, At, B0); PG8_BAR; PG8_SCHED;
            PG8_LDB(B1, 1, 1); PG8_STAGE(PG8_SB(1, 0), b3, voffB);
            PG8_BAR; PG8_WAIT_L(0); PG8_MMA(0, 1, At, B1); PG8_BAR;
            PG8_LDA(At, 1, 1); PG8_STAGE(PG8_SA(1, 0), a3, voffA);
            PG8_BAR; PG8_WAIT_L(0); PG8_MMA(1, 0, At, B0); PG8_BAR; PG8_SCHED;
            PG8_STAGE(PG8_SB(1, 1), b3 + hstep, voffB);
            PG8_WAIT_V(6); PG8_BAR; PG8_MMA(1, 1, At, B1); PG8_BAR;
            }
        }
        if constexpr (ALIGN_EPI) { if (wr == 0) PG8_BAR; }
        if constexpr (!Epi::AFTER_DRAIN) { E(acc, cur, wr, wc, fr, fq); S.done(cur); }
        if (!has_next) break;
#pragma unroll
        for (int a = 0; a < 2; ++a)
#pragma unroll
            for (int b = 0; b < 2; ++b)
#pragma unroll
                for (int m = 0; m < 4; ++m)
#pragma unroll
                    for (int n = 0; n < 2; ++n) acc[a][b][m][n] = (f32x4){0.f, 0.f, 0.f, 0.f};
        cur = nxt; cA = nA; cB = nB; ++ui;
        if constexpr (ALIGN_EPI) { if (wr == 1) PG8_BAR; }
    }
    PG8_WAIT_V(0);
    if constexpr (!ALIGN_EPI) { if (wr == 0) PG8_BAR; }
    PG8_BAR;
    if constexpr (Epi::AFTER_DRAIN) { E.fused(acc, cur, wr, wc, fr, fq, lds, wid, lane); S.done(cur); }
#undef PG8_SA
#undef PG8_SB
#undef PG8_STAGE
#undef PG8_LDA
#undef PG8_LDB
#undef PG8_MMA
#undef PG8_WAIT_V
#undef PG8_WAIT_L
#undef PG8_BAR
#undef PG8_SCHED
}
}
#define PG8_SP2 true
#define PG8_ALIGN true
__device__ __forceinline__ void phase_rope(Frame& F) {
    unsigned char* ws = F.a->ws; bf16_t* ZX = (bf16_t*)(ws + WS_ZX); const float* C = (const float*)(ws + WS_COS); const float* S = (const float*)(ws + WS_SIN);
    for (int t = F.gw; t < M; t += F.ngw) {
        bf16_t* row = ZX + (size_t)t * NP;
#pragma unroll
        for (int j = 0; j < 8; ++j) { const int idx = F.lane + 64 * j; const int tensor = idx >> 8, grp = (idx >> 5) & 7, i = idx & 31;
            const int cl = (tensor ? CK : CQ) + grp * 64 + i; const float cs = C[t * 32 + i], sn = S[t * 32 + i];
            const float x1 = bf2f(row[cl]), x2 = bf2f(row[cl + 32]); const float sc = tensor ? 1.f : C2_DIFF;
            row[cl] = f2bf((x1 * cs - x2 * sn) * sc); row[cl + 32] = f2bf((x2 * cs + x1 * sn) * sc); }
    }
}

template <class Fn>
__device__ __forceinline__ void ssd_conv(Frame& F, int b, int c, int xc0, int ncols, const Fn& fn) {
    const bf16_t* ZX = (const bf16_t*)(F.a->ws + WS_ZX); const float* cw = F.a->in[11]; const float* cb = F.a->in[12];
    for (int e = F.tid; e < 128 * ncols; e += NTHREADS) { const int l = e / ncols, j = e % ncols, xc = xc0 + j; const int s = c * CHUNK + l;
        float acc = cb[xc];
#pragma unroll
        for (int w = 0; w < 4; ++w) { const int ss = s - 3 + w; if (ss >= 0) acc += cw[w * 1024 + xc] * bf2f(ZX[(size_t)(b * SEQ + ss) * NP + CXBC + xc]); }
        fn(l, j, silu_f(acc)); }
}
__device__ __forceinline__ void ssd_dt_cum(Frame& F, int b, int c, int h, float* dtl, float* cuml) {
    const float* DT = (const float*)(F.a->ws + WS_DT);
    if (F.tid < 128) { const float dt = softplus_f(DT[(size_t)(b * SEQ + c * CHUNK + F.tid) * 8 + h] + F.a->in[13][h]); const float a = -expf(F.a->in[14][h]); dtl[F.tid] = dt; cuml[F.tid] = dt * a; }
    __syncthreads();
    if (F.tid == 0) { float s = 0.f; for (int l = 0; l < 128; ++l) { s += cuml[l]; cuml[l] = s; } }
    __syncthreads();
}
__device__ __forceinline__ void phase_ssd_states(Frame& F) {
    float* xw = (float*)F.lds; float* Bm = (float*)(F.lds + 32768); float* dtl = (float*)(F.lds + 98304); float* cuml = dtl + 128;
    float* ST = (float*)(F.a->ws + WS_ST); float* DEC = (float*)(F.a->ws + WS_DEC);
    for (int u = blockIdx.x; u < BATCH * NCH * SSD_H; u += gridDim.x) {
        const int h = u & 7, c = (u >> 3) & 15, b = u >> 7, g = h >> 2;
        ssd_dt_cum(F, b, c, h, dtl, cuml);
        const float clast = cuml[127];
        ssd_conv(F, b, c, h * 64, 64, [&](int l, int j, float v) { xw[l * 64 + j] = v * dtl[l] * expf(clast - cuml[l]); });
        ssd_conv(F, b, c, 512 + g * 128, 128, [&](int l, int j, float v) { Bm[l * 128 + j] = bf2f(f2bf(v)); });
        __syncthreads();
        const int p = F.tid >> 3, n0 = (F.tid & 7) * 16;
        float acc[16];
#pragma unroll
        for (int i = 0; i < 16; ++i) acc[i] = 0.f;
        for (int l = 0; l < 128; ++l) { const float xv = xw[l * 64 + p];
#pragma unroll
            for (int i = 0; i < 16; ++i) acc[i] += xv * Bm[l * 128 + n0 + i]; }
        float* dst = ST + ((size_t)u * 64 + p) * 128 + n0;
#pragma unroll
        for (int i = 0; i < 16; i += 4) *(f32x4*)(dst + i) = (f32x4){acc[i], acc[i + 1], acc[i + 2], acc[i + 3]};
        if (F.tid == 0) DEC[u] = expf(clast);
        __syncthreads();
    }
}
__device__ __forceinline__ void phase_ssd_y(Frame& F) {
    bf16_t* Cb = (bf16_t*)F.lds; bf16_t* Bb = (bf16_t*)(F.lds + 32768); float* Hin = (float*)(F.lds + 32768); bf16_t* Mb = (bf16_t*)(F.lds + 65536);
    float* xs = (float*)(F.lds + 98304); float* dtl = (float*)(F.lds + 131072); float* cuml = dtl + 128;
    const float* ST = (const float*)(F.a->ws + WS_ST); const float* DEC = (const float*)(F.a->ws + WS_DEC);
    const bf16_t* ZX = (const bf16_t*)(F.a->ws + WS_ZX); bf16_t* Y = (bf16_t*)(F.a->ws + WS_Y); float* SSQ = (float*)(F.a->ws + WS_SSQ);
    for (int u = blockIdx.x; u < BATCH * NCH * SSD_H; u += gridDim.x) {
        const int h = u & 7, c = (u >> 3) & 15, b = u >> 7, g = h >> 2;
        ssd_dt_cum(F, b, c, h, dtl, cuml);
        ssd_conv(F, b, c, h * 64, 64, [&](int l, int j, float v) { xs[l * 64 + j] = bf2f(f2bf(v)); });
        ssd_conv(F, b, c, 512 + g * 128, 128, [&](int l, int j, float v) { Bb[l * 128 + j] = f2bf(v); });
        ssd_conv(F, b, c, 768 + g * 128, 128, [&](int l, int j, float v) { Cb[l * 128 + j] = f2bf(v); });
        __syncthreads();
        {
            const int l = F.tid >> 2; const float cl = cuml[l];
#pragma unroll 1
            for (int half = 0; half < 2; ++half) {
                const int s0 = (F.tid & 3) * 32 + half * 16;
                float acc[16];
#pragma unroll
                for (int i = 0; i < 16; ++i) acc[i] = 0.f;
#pragma unroll 1
                for (int nb = 0; nb < 16; ++nb) {
                    const bf16x8 c8 = *(const bf16x8*)(Cb + l * 128 + nb * 8); float cf[8];
#pragma unroll
                    for (int q = 0; q < 8; ++q) cf[q] = bf2f((bf16_t)c8[q]);
#pragma unroll
                    for (int i = 0; i < 16; ++i) { const bf16x8 b8 = *(const bf16x8*)(Bb + (s0 + i) * 128 + nb * 8);
#pragma unroll
                        for (int q = 0; q < 8; ++q) acc[i] += cf[q] * bf2f((bf16_t)b8[q]); }
                }
#pragma unroll
                for (int i = 0; i < 16; ++i) { const int s = s0 + i; Mb[l * 128 + s] = f2bf(s <= l ? acc[i] * expf(cl - cuml[s]) * dtl[s] : 0.f); }
            }
        }
        __syncthreads();
        {
            const int p = F.tid >> 3, n0 = (F.tid & 7) * 16;
            float hc[16];
#pragma unroll
            for (int i = 0; i < 16; ++i) hc[i] = 0.f;
            for (int j = 0; j < c; ++j) { const int uj = (b * NCH + j) * 8 + h; const float d = DEC[uj]; const float* src = ST + ((size_t)uj * 64 + p) * 128 + n0;
#pragma unroll
                for (int i = 0; i < 16; i += 4) { const f32x4 sv = *(const f32x4*)(src + i); hc[i] = hc[i] * d + sv.x; hc[i + 1] = hc[i + 1] * d + sv.y; hc[i + 2] = hc[i + 2] * d + sv.z; hc[i + 3] = hc[i + 3] * d + sv.w; } }
#pragma unroll
            for (int i = 0; i < 16; ++i) Hin[(n0 + i) * 64 + p] = hc[i];
        }
        __syncthreads();
        {
            const int l = F.tid >> 2, p0 = (F.tid & 3) * 16;
            float yd[16], yo[16];
#pragma unroll
            for (int i = 0; i < 16; ++i) { yd[i] = 0.f; yo[i] = 0.f; }
            for (int s = 0; s <= l; ++s) { const float mv = bf2f(Mb[l * 128 + s]);
#pragma unroll
                for (int i = 0; i < 16; ++i) yd[i] += mv * xs[s * 64 + p0 + i]; }
            for (int n = 0; n < 128; ++n) { const float cv = bf2f(Cb[l * 128 + n]);
#pragma unroll
                for (int i = 0; i < 16; ++i) yo[i] += cv * Hin[n * 64 + p0 + i]; }
            const float ec = expf(cuml[l]), dsk = F.a->in[15][h]; const size_t t = (size_t)(b * SEQ + c * CHUNK + l);
            float ssq = 0.f; float vv[16];
#pragma unroll
            for (int i = 0; i < 16; ++i) { const float y = yd[i] + ec * yo[i] + dsk * xs[l * 64 + p0 + i]; const float z = bf2f(ZX[t * NP + CZ + h * 64 + p0 + i]); const float v = y * silu_f(z); vv[i] = v; ssq += v * v; }
            ssq += __shfl_xor(ssq, 1); ssq += __shfl_xor(ssq, 2);
            bf16_t* yo_p = Y + t * DM + h * 64 + p0;
#pragma unroll
            for (int i = 0; i < 16; i += 4) { uint2 o; o.x = pk2(vv[i], vv[i + 1]); o.y = pk2(vv[i + 2], vv[i + 3]); *(uint2*)(yo_p + i) = o; }
            if ((F.tid & 3) == 0) SSQ[t * 8 + h] = ssq;
        }
        __syncthreads();
    }
}
__device__ __forceinline__ void phase_ssd_norm(Frame& F) {
    bf16_t* Y = (bf16_t*)(F.a->ws + WS_Y); const float* SSQ = (const float*)(F.a->ws + WS_SSQ); const float* w = F.a->in[16];
    for (int t = F.gw; t < M; t += F.ngw) {
        float s = 0.f;
#pragma unroll
        for (int h = 0; h < 8; ++h) s += SSQ[(size_t)t * 8 + h];
        const float r = 1.0f / sqrtf(s * (1.f / D_SSD) + EPS);
        bf16_t* row = Y + (size_t)t * DM;
#pragma unroll
        for (int j = 0; j < 2; ++j) { const int col = (F.lane + 64 * j) * 4; uint2 o = *(uint2*)(row + col); const f32x4 wv = *(const f32x4*)(w + col);
            const float a0 = bf2f((bf16_t)(o.x & 0xffff)) * r * wv.x, a1 = bf2f((bf16_t)(o.x >> 16)) * r * wv.y, a2 = bf2f((bf16_t)(o.y & 0xffff)) * r * wv.z, a3 = bf2f((bf16_t)(o.y >> 16)) * r * wv.w;
            o.x = pk2(a0, a1); o.y = pk2(a2, a3); *(uint2*)(row + col) = o; }
    }
}

__device__ __forceinline__ void phase_diff_attn(Frame& F) {
    float* Ks = (float*)F.lds; float* Vs = (float*)(F.lds + 32768); float* Ot = (float*)(F.lds + 65536);
    const bf16_t* ZX = (const bf16_t*)(F.a->ws + WS_ZX); bf16_t* Y = (bf16_t*)(F.a->ws + WS_Y);
    const int pair = F.tid >> 2, row = pair & 63, comp = pair >> 6, sub = F.tid & 3;
    const int NU = BATCH * DH * (SEQ / 64);
    for (int uu = blockIdx.x; uu < NU; uu += gridDim.x) {
        const int qblk = 31 - (uu / (BATCH * DH)), bh = uu % (BATCH * DH), b = bh / DH, h = bh % DH;
        const int qidx = qblk * 64 + row; const size_t tq = (size_t)b * SEQ + qidx;
        float q[16];
#pragma unroll
        for (int i = 0; i < 16; ++i) q[i] = bf2f(ZX[tq * NP + CQ + h * 128 + comp * 64 + sub * 16 + i]);
        float o[32];
#pragma unroll
        for (int i = 0; i < 32; ++i) o[i] = 0.f;
        float mrun = -INFINITY, lrun = 0.f;
        for (int kt = 0; kt <= qblk; ++kt) {
            __syncthreads();
            for (int e = F.tid; e < 8192; e += NTHREADS) { const int cp = e >> 12, j = (e >> 6) & 63, d = e & 63; Ks[e] = bf2f(ZX[((size_t)b * SEQ + kt * 64 + j) * NP + CK + h * 128 + cp * 64 + d]); }
            for (int e = F.tid; e < 8192; e += NTHREADS) { const int j = e >> 7, d = e & 127; Vs[e] = bf2f(ZX[((size_t)b * SEQ + kt * 64 + j) * NP + CV + h * 128 + d]); }
            __syncthreads();
            _Pragma("unroll 1") for (int jb = 0; jb < 8; ++jb) {
                float s[8];
#pragma unroll
                for (int jj = 0; jj < 8; ++jj) { const float* kr = Ks + comp * 4096 + (jb * 8 + jj) * 64 + sub * 16; float a = 0.f;
#pragma unroll
                    for (int i = 0; i < 16; ++i) a += q[i] * kr[i];
                    a += __shfl_xor(a, 1); a += __shfl_xor(a, 2);
                    const int kidx = kt * 64 + jb * 8 + jj; s[jj] = (kidx > qidx) ? -INFINITY : a; }
                float mx = s[0];
#pragma unroll
                for (int jj = 1; jj < 8; ++jj) mx = fmaxf(mx, s[jj]);
                const float mnew = fmaxf(mrun, mx);
                if (mnew > -INFINITY) {
                    const float alpha = exp2f(mrun - mnew); lrun *= alpha;
#pragma unroll
                    for (int i = 0; i < 32; ++i) o[i] *= alpha;
#pragma unroll
                    for (int jj = 0; jj < 8; ++jj) { const float p = exp2f(s[jj] - mnew); lrun += p; const float* vr = Vs + (jb * 8 + jj) * 128 + sub * 32;
#pragma unroll
                        for (int i = 0; i < 32; ++i) o[i] += p * vr[i]; }
                    mrun = mnew;
                }
            }
        }
        const float il = 1.f / lrun;
        __syncthreads();
        if (comp == 1) {
#pragma unroll
            for (int i = 0; i < 32; ++i) Ot[row * 128 + sub * 32 + i] = o[i] * il; }
        __syncthreads();
        if (comp == 0) {
            float a1 = 0.f, a2 = 0.f;
            for (int i = 0; i < 64; ++i) { a1 += F.a->in[17][i] * F.a->in[18][i]; a2 += F.a->in[19][i] * F.a->in[20][i]; }
            const float lam = expf(a1) - expf(a2) + LAMBDA_INIT;
            float ss = 0.f;
#pragma unroll
            for (int i = 0; i < 32; ++i) { o[i] = o[i] * il - lam * Ot[row * 128 + sub * 32 + i]; ss += o[i] * o[i]; }
            ss += __shfl_xor(ss, 1); ss += __shfl_xor(ss, 2);
            const float r = (1.0f / sqrtf(ss * (1.f / 128.f) + EPS)) * (1.f - LAMBDA_INIT);
            bf16_t* dst = Y + tq * DM + 512 + h * 128 + sub * 32; const float* sw = F.a->in[21] + sub * 32;
#pragma unroll
            for (int i = 0; i < 32; i += 2) *(unsigned*)(dst + i) = pk2(o[i] * r * sw[i], o[i + 1] * r * sw[i + 1]);
        }
    }
    __syncthreads();
}

namespace dattn {
typedef float f32x16 __attribute__((ext_vector_type(16)));
typedef short s16x4 __attribute__((ext_vector_type(4)));
typedef short v4i16_t __attribute__((ext_vector_type(4)));
#define DA_LAS __attribute__((address_space(3)))
constexpr int SLOT = 32768, K2_OFF = 8192, V_OFF = 16384, STG_PITCH = 132, WSF_OFF = 2 * 128 * STG_PITCH * 4;
__device__ __forceinline__ int crow(int r, int hi) { return (r & 3) + 8 * (r >> 2) + 4 * hi; }
typedef float f32x2_t __attribute__((ext_vector_type(2))); typedef __bf16 bf16x2_t __attribute__((ext_vector_type(2)));
__device__ __forceinline__ unsigned cvtpk(float lo, float hi) { f32x2_t v = {lo, hi}; bf16x2_t b = __builtin_convertvector(v, bf16x2_t); return __builtin_bit_cast(unsigned, b); }
__device__ __forceinline__ s16x4 vtr(const DA_LAS unsigned char* p) { return __builtin_bit_cast(s16x4, __builtin_amdgcn_ds_read_tr16_b64_v4i16((DA_LAS v4i16_t*)p)); }
__device__ __forceinline__ float swap_max(float m) { auto rr = __builtin_amdgcn_permlane32_swap(__float_as_uint(m), __float_as_uint(m), false, false); return fmaxf(__uint_as_float(rr[0]), __uint_as_float(rr[1])); }
__device__ __forceinline__ float swap_sum(float m) { auto rr = __builtin_amdgcn_permlane32_swap(__float_as_uint(m), __float_as_uint(m), false, false); return __uint_as_float(rr[0]) + __uint_as_float(rr[1]); }

template <int THR>
__device__ __forceinline__ void unit(Frame& F, DA_LAS unsigned char* lds, int b, int h, int qb, float lam) {
    const int tid = F.tid, lane = tid & 63, r32 = lane & 31, hi = lane >> 5; const int wid = __builtin_amdgcn_readfirstlane(tid >> 6), comp = wid >> 2, wq = wid & 3;
    const bf16_t* ZX = (const bf16_t*)(F.a->ws + WS_ZX);
    const size_t rowbase = (size_t)b * SEQ; const int q0 = qb * 128, NT = 2 * (qb + 1);
    const bf16_t* k1src = ZX + (rowbase + lane) * NP + CK + h * 128 + wid * 8;
    const bf16_t* vsrc0 = ZX + (rowbase + 16 * ((2 * wid) & 3) + (lane >> 2)) * NP + CV + h * 128 + 32 * ((2 * wid) >> 2) + (lane & 3) * 8;
    const bf16_t* vsrc1 = ZX + (rowbase + 16 * ((2 * wid + 1) & 3) + (lane >> 2)) * NP + CV + h * 128 + 32 * ((2 * wid + 1) >> 2) + (lane & 3) * 8;
#define DA_DMA(t, slot) do { const size_t go_ = (size_t)(t) * 64 * NP; DA_LAS unsigned char* sl_ = lds + (slot) * SLOT; \
        __builtin_amdgcn_global_load_lds((const unsigned*)(k1src + go_), (DA_LAS unsigned*)(sl_ + wid * 1024), 16, 0, 0); \
        __builtin_amdgcn_global_load_lds((const unsigned*)(k1src + go_ + 64), (DA_LAS unsigned*)(sl_ + K2_OFF + wid * 1024), 16, 0, 0); \
        __builtin_amdgcn_global_load_lds((const unsigned*)(vsrc0 + go_), (DA_LAS unsigned*)(sl_ + V_OFF + (2 * wid) * 1024), 16, 0, 0); \
        __builtin_amdgcn_global_load_lds((const unsigned*)(vsrc1 + go_), (DA_LAS unsigned*)(sl_ + V_OFF + (2 * wid + 1) * 1024), 16, 0, 0); } while (0)
    DA_DMA(0, 0);
    const bf16_t* Qw = ZX + (rowbase + q0 + wq * 32 + r32) * NP + CQ + h * 128 + comp * 64 + hi * 8;
    bf16x8 qr[4];
#pragma unroll
    for (int d0 = 0; d0 < 4; ++d0) qr[d0] = *(const bf16x8*)(Qw + d0 * 16);
    float mhat = 0.f, l_reg = 0.f; f32x16 o[4];
#pragma unroll
    for (int d = 0; d < 4; ++d) o[d] = f32x16{};
    DA_LAS float* wsf = (DA_LAS float*)(lds + WSF_OFF) + wid * 64;
    const int qabs = q0 + wq * 32 + r32;
    asm volatile("s_waitcnt vmcnt(0)" ::: "memory"); __syncthreads();
    for (int t = 0; t < NT; ++t) {
        const int cur = t & 1;
        if (t + 1 < NT) DA_DMA(t + 1, cur ^ 1);
        const bool active = (64 * t <= q0 + wq * 32 + 31);
        if (active) {
            const DA_LAS unsigned char* kb = lds + cur * SLOT + (comp ? K2_OFF : 0) + hi * 1024 + r32 * 16;
            f32x16 p0 = f32x16{}, p1 = f32x16{};
#pragma unroll
            for (int d0 = 0; d0 < 4; ++d0) { const bf16x8 k0 = *(const DA_LAS bf16x8*)(kb + d0 * 2048), k1 = *(const DA_LAS bf16x8*)(kb + d0 * 2048 + 512);
                p0 = __builtin_amdgcn_mfma_f32_32x32x16_bf16(k0, qr[d0], p0, 0, 0, 0); p1 = __builtin_amdgcn_mfma_f32_32x32x16_bf16(k1, qr[d0], p1, 0, 0, 0); }
            if (t >= NT - 2) {
#pragma unroll
                for (int r = 0; r < 16; ++r) { const int kv = 64 * t + crow(r, hi); if (kv > qabs) p0[r] = -INFINITY; if (kv + 32 > qabs) p1[r] = -INFINITY; }
            }
            float rm = fmaxf(p0[0], p1[0]);
#pragma unroll
            for (int r = 1; r < 16; ++r) rm = fmaxf(rm, fmaxf(p0[r], p1[r]));
            rm = swap_max(rm);
            if (t == 0) { mhat = rm; }
            else if (__any(rm > mhat + (float)THR)) {
                const float dl = fmaxf(rm - mhat, 0.f); mhat += dl; const float f = __builtin_amdgcn_exp2f(-dl); l_reg *= f;
                if (hi == 0) wsf[r32] = f;
                asm volatile("s_waitcnt lgkmcnt(0)" ::: "memory");
#pragma unroll
                for (int r = 0; r < 16; ++r) { const float fr_ = wsf[crow(r, hi)];
#pragma unroll
                    for (int d = 0; d < 4; ++d) o[d][r] *= fr_; }
            }
            float sacc = 0.f;
#pragma unroll
            for (int r = 0; r < 16; ++r) { p0[r] = __builtin_amdgcn_exp2f(p0[r] - mhat); p1[r] = __builtin_amdgcn_exp2f(p1[r] - mhat); sacc += p0[r] + p1[r]; }
            l_reg += sacc;
            bf16x8 pa[4];
            { unsigned w_[16];
#pragma unroll
              for (int i = 0; i < 8; ++i) { w_[i] = cvtpk(p0[2 * i], p0[2 * i + 1]); w_[8 + i] = cvtpk(p1[2 * i], p1[2 * i + 1]); }
#pragma unroll
              for (int k = 0; k < 4; ++k) { u32x4_t x = {w_[4 * k], w_[4 * k + 1], w_[4 * k + 2], w_[4 * k + 3]}; pa[k] = __builtin_bit_cast(bf16x8, x); } }
            const DA_LAS unsigned char* vb = lds + cur * SLOT + V_OFF + ((lane >> 4) & 1) * 32 + (lane & 3) * 8 + (4 * hi + ((lane & 15) >> 2)) * 64;
#pragma unroll
            for (int d = 0; d < 4; ++d) {
#pragma unroll
                for (int ks = 0; ks < 4; ++ks) { const s16x4 lo = vtr(vb + d * 4096 + ks * 1024), hh = vtr(vb + d * 4096 + ks * 1024 + 512);
                    const bf16x8 vf = (bf16x8){lo[0], lo[1], lo[2], lo[3], hh[0], hh[1], hh[2], hh[3]};
                    o[d] = __builtin_amdgcn_mfma_f32_32x32x16_bf16(pa[ks], vf, o[d], 0, 0, 0); }
            }
        }
        asm volatile("s_waitcnt vmcnt(0) lgkmcnt(0)" ::: "memory"); __syncthreads();
    }
#undef DA_DMA
    l_reg = swap_sum(l_reg);
    if (hi == 0) wsf[32 + r32] = l_reg;
    asm volatile("s_waitcnt lgkmcnt(0)" ::: "memory");
    DA_LAS float* stg = (DA_LAS float*)lds + comp * (128 * STG_PITCH);
#pragma unroll
    for (int r = 0; r < 16; ++r) { const float rl = 1.0f / wsf[32 + crow(r, hi)]; const int row = wq * 32 + crow(r, hi);
#pragma unroll
        for (int d = 0; d < 4; ++d) stg[row * STG_PITCH + d * 32 + r32] = o[d][r] * rl; }
    __syncthreads();
    {
        const int row = tid >> 2, seg = tid & 3; const DA_LAS float* s1 = (const DA_LAS float*)lds + row * STG_PITCH + seg * 32; const DA_LAS float* s2 = s1 + 128 * STG_PITCH;
        float v[32]; float ss = 0.f;
#pragma unroll
        for (int i = 0; i < 32; i += 4) { const f32x4 a = *(const DA_LAS f32x4*)(s1 + i), c = *(const DA_LAS f32x4*)(s2 + i);
            v[i] = a.x - lam * c.x; v[i + 1] = a.y - lam * c.y; v[i + 2] = a.z - lam * c.z; v[i + 3] = a.w - lam * c.w;
            ss += (v[i] * v[i] + v[i + 1] * v[i + 1]) + (v[i + 2] * v[i + 2] + v[i + 3] * v[i + 3]); }
        ss += __shfl_xor(ss, 1); ss += __shfl_xor(ss, 2);
        const float rs = (1.0f / sqrtf(ss * (1.f / 128.f) + EPS)) * (1.f - LAMBDA_INIT);
        const float* sw = F.a->in[21] + seg * 32; bf16_t* dst = (bf16_t*)(F.a->ws + WS_Y) + (rowbase + q0 + row) * DM + 512 + h * 128 + seg * 32;
#pragma unroll
        for (int i = 0; i < 32; i += 8) { uint4 ov; ov.x = pk2(v[i] * rs * sw[i], v[i + 1] * rs * sw[i + 1]); ov.y = pk2(v[i + 2] * rs * sw[i + 2], v[i + 3] * rs * sw[i + 3]);
            ov.z = pk2(v[i + 4] * rs * sw[i + 4], v[i + 5] * rs * sw[i + 5]); ov.w = pk2(v[i + 6] * rs * sw[i + 6], v[i + 7] * rs * sw[i + 7]); *(uint4*)(dst + i) = ov; }
    }
    __syncthreads();
}
}
__device__ __forceinline__ void phase_diff_attn_mfma(Frame& F) {
    float a1 = 0.f, a2 = 0.f;
    for (int i = 0; i < 64; ++i) { a1 += F.a->in[17][i] * F.a->in[18][i]; a2 += F.a->in[19][i] * F.a->in[20][i]; }
    const float lam = expf(a1) - expf(a2) + LAMBDA_INIT;
    const int G = gridDim.x, bx = blockIdx.x; const int vcu = (G % 8 == 0) ? (bx % 8) * (G / 8) + bx / 8 : bx;
    for (int v = vcu; v < 256; v += G) { const int bh = v >> 3, s_ = v & 7;
        dattn::unit<0>(F, (DA_LAS unsigned char*)F.lds, bh >> 2, bh & 3, 15 - s_, lam);
        dattn::unit<0>(F, (DA_LAS unsigned char*)F.lds, bh >> 2, bh & 3, s_, lam); }
}

namespace ssd {
using dattn::f32x16; using dattn::s16x4; using dattn::crow; using dattn::cvtpk; using dattn::vtr; using dattn::swap_sum;
__device__ __forceinline__ bf16x8 trfrag(const DA_LAS unsigned char* sub, int vlane) { const s16x4 lo = vtr(sub + vlane), hh = vtr(sub + vlane + 512); return (bf16x8){lo[0], lo[1], lo[2], lo[3], hh[0], hh[1], hh[2], hh[3]}; }

__device__ __forceinline__ void pass_a(Frame& F, DA_LAS unsigned char* lds, int b, int c, int g) {
    constexpr int XW_OFF = 0, BT_OFF = 65536, DTC_OFF = 98304;
    const int tid = F.tid, lane = tid & 63, r32 = lane & 31, hi = lane >> 5; const int wid = __builtin_amdgcn_readfirstlane(tid >> 6);
    unsigned char* ws = F.a->ws; const size_t t0 = (size_t)b * SEQ + c * CHUNK;
    DA_LAS float* dtl = (DA_LAS float*)(lds + DTC_OFF); DA_LAS float* cum = dtl + 512;
    float* DTL = (float*)(ws + WS_DTL); float* CUMG = (float*)(ws + WS_CUM);
    { const int hh = tid >> 7, l = tid & 127, h = 4 * g + hh;
      const float dt = softplus_f(((const float*)(ws + WS_DT))[(t0 + l) * 8 + h] + F.a->in[13][h]); const float a = -expf(F.a->in[14][h]);
      dtl[tid] = dt; cum[tid] = dt * a; DTL[(t0 + l) * 8 + h] = dt;
      __syncthreads();
      float sacc = 0.f; for (int i = 0; i <= l; ++i) sacc += cum[hh * 128 + i];
      __syncthreads();
      cum[tid] = sacc; CUMG[(t0 + l) * 8 + h] = sacc; }
    __syncthreads();
    {
        const int cp = tid & 255, lh = tid >> 8, lc = 2 * cp; const int cls = lc >> 7;
        const int xc = (cls < 2) ? g * 256 + lc : (cls == 2 ? 512 + g * 128 + (lc - 256) : 768 + g * 128 + (lc - 384));
        const float* cw = F.a->in[11]; const float* cb = F.a->in[12];
        const float w00 = cw[xc], w01 = cw[xc + 1], w10 = cw[1024 + xc], w11 = cw[1024 + xc + 1], w20 = cw[2048 + xc], w21 = cw[2048 + xc + 1], w30 = cw[3072 + xc], w31 = cw[3072 + xc + 1], b0 = cb[xc], b1 = cb[xc + 1];
        const bf16_t* ZX = (const bf16_t*)(ws + WS_ZX); bf16_t* XC = (bf16_t*)(ws + WS_XC);
        const int hh = (lc >> 6) & 3; const float clast = cum[hh * 128 + 127];
        float x0a = 0.f, x0b = 0.f, x1a = 0.f, x1b = 0.f, x2a = 0.f, x2b = 0.f;
#pragma unroll
        for (int i = 0; i < 3; ++i) { const int s_ = c * CHUNK + 64 * lh - 3 + i; unsigned u = 0u; if (s_ >= 0) u = *(const unsigned*)(ZX + ((size_t)b * SEQ + s_) * NP + CXBC + xc);
            x0a = x1a; x0b = x1b; x1a = x2a; x1b = x2b; x2a = __uint_as_float(u << 16); x2b = __uint_as_float(u & 0xffff0000u); }
#pragma unroll 8
        for (int i = 0; i < 64; ++i) { const int l = 64 * lh + i; const unsigned u = *(const unsigned*)(ZX + (t0 + l) * NP + CXBC + xc);
            const float xa = __uint_as_float(u << 16), xb = __uint_as_float(u & 0xffff0000u);
            const float va = silu_f(b0 + w00 * x0a + w10 * x1a + w20 * x2a + w30 * xa), vb = silu_f(b1 + w01 * x0b + w11 * x1b + w21 * x2b + w31 * xb);
            x0a = x1a; x0b = x1b; x1a = x2a; x1b = x2b; x2a = xa; x2b = xb;
            *(unsigned*)(XC + (t0 + l) * 1024 + xc) = pk2(va, vb);
            if (cls < 2) { const float sc = dtl[hh * 128 + l] * expf(clast - cum[hh * 128 + l]);
                *(DA_LAS unsigned*)(lds + XW_OFF + ((l >> 4) * 8 + (lc >> 5)) * 1024 + (l & 15) * 64 + (lc & 31) * 2) = pk2(va * sc, vb * sc); }
            else if (cls == 2) { *(DA_LAS unsigned*)(lds + BT_OFF + ((l >> 4) * 4 + ((lc - 256) >> 5)) * 1024 + (l & 15) * 64 + (lc & 31) * 2) = pk2(va, vb); }
        }
    }
    __syncthreads();
    {
        const int hh = wid >> 1, nh = wid & 1; const int vlane = ((lane >> 4) & 1) * 32 + (lane & 3) * 8 + (4 * hi + ((lane & 15) >> 2)) * 64;
        f32x16 acc[2][2];
#pragma unroll
        for (int i = 0; i < 2; ++i)
#pragma unroll
            for (int j = 0; j < 2; ++j) acc[i][j] = f32x16{};
#pragma unroll
        for (int ks = 0; ks < 8; ++ks) { bf16x8 af[2], bfv[2];
#pragma unroll
            for (int pb = 0; pb < 2; ++pb) af[pb] = trfrag(lds + XW_OFF + (ks * 8 + hh * 2 + pb) * 1024, vlane);
#pragma unroll
            for (int nb = 0; nb < 2; ++nb) bfv[nb] = trfrag(lds + BT_OFF + (ks * 4 + nh * 2 + nb) * 1024, vlane);
#pragma unroll
            for (int pb = 0; pb < 2; ++pb)
#pragma unroll
                for (int nb = 0; nb < 2; ++nb) acc[pb][nb] = __builtin_amdgcn_mfma_f32_32x32x16_bf16(af[pb], bfv[nb], acc[pb][nb], 0, 0, 0); }
        const int u = (b * NCH + c) * 8 + 4 * g + hh; float* ST = (float*)(ws + WS_ST) + (size_t)u * 8192;
#pragma unroll
        for (int pb = 0; pb < 2; ++pb)
#pragma unroll
            for (int nb = 0; nb < 2; ++nb)
#pragma unroll
                for (int r = 0; r < 16; ++r) ST[(32 * pb + crow(r, hi)) * 128 + 64 * nh + 32 * nb + r32] = acc[pb][nb][r];
        if (nh == 0 && lane == 0) ((float*)(ws + WS_DEC))[u] = expf(cum[hh * 128 + 127]);
    }
    __syncthreads();
}
__device__ __forceinline__ void scan_item(Frame& F, int bh, int quarter) {
    unsigned char* ws = F.a->ws; const int b = bh >> 3, h = bh & 7; const int p = quarter * 16 + (F.tid >> 5), n0 = (F.tid & 31) * 4;
    const float* ST = (const float*)(ws + WS_ST); const float* DEC = (const float*)(ws + WS_DEC); bf16_t* HIN = (bf16_t*)F.a->out;
    f32x4 sv[NCH]; float dc[NCH];
#pragma unroll
    for (int c = 0; c < NCH; ++c) { const int u = (b * NCH + c) * 8 + h; sv[c] = *(const f32x4*)(ST + (size_t)u * 8192 + p * 128 + n0); dc[c] = DEC[u]; }
    f32x4 hc = (f32x4){0.f, 0.f, 0.f, 0.f};
#pragma unroll
    for (int c = 0; c < NCH; ++c) { const int u = (b * NCH + c) * 8 + h; uint2 o; o.x = pk2(hc.x, hc.y); o.y = pk2(hc.z, hc.w);
        *(uint2*)(HIN + (size_t)u * 8192 + ((n0 >> 3) * 64 + p) * 8 + (n0 & 7)) = o; hc = hc * dc[c] + sv[c]; }
}
__device__ __forceinline__ void pass_b(Frame& F, DA_LAS unsigned char* lds, int b, int c, int g, int hp) {
    constexpr int BC_OFF = 0, CC_OFF = 32768, XS_OFF = 65536, HIN_OFF = 98304, DTC_OFF = 131072;
    const int tid = F.tid, lane = tid & 63, r32 = lane & 31, hi = lane >> 5; const int wid = __builtin_amdgcn_readfirstlane(tid >> 6);
    unsigned char* ws = F.a->ws; const size_t t0 = (size_t)b * SEQ + c * CHUNK;
    const bf16_t* XC = (const bf16_t*)(ws + WS_XC); const bf16_t* HIN = (const bf16_t*)F.a->out;
    const int hh2 = wid >> 2, lq = wid & 3, h = 4 * g + 2 * hp + hh2;
#pragma unroll
    for (int i = 0; i < 16; ++i) { const int idx = wid * 16 + i, typ = idx >> 5, k = idx & 31; const bf16_t* src; int dst;
        if (typ < 2) { const int ch = k >> 1, rb = k & 1; src = XC + (t0 + 64 * rb + lane) * 1024 + (typ ? 768 : 512) + g * 128 + ch * 8; dst = (typ ? CC_OFF : BC_OFF) + ch * 2048 + rb * 1024; }
        else if (typ == 2) { const int lg = k >> 2, cb = k & 3; src = XC + (t0 + 16 * lg + (lane >> 2)) * 1024 + g * 256 + hp * 128 + 32 * cb + (lane & 3) * 8; dst = XS_OFF + k * 1024; }
        else { const int h2 = k >> 4, ch = k & 15; const int u = (b * NCH + c) * 8 + 4 * g + 2 * hp + h2; src = HIN + (size_t)u * 8192 + ch * 512 + lane * 8; dst = HIN_OFF + h2 * 16384 + ch * 1024; }
        __builtin_amdgcn_global_load_lds((const unsigned*)src, (DA_LAS unsigned*)(lds + dst), 16, 0, 0); }
    DA_LAS float* dtl = (DA_LAS float*)(lds + DTC_OFF); DA_LAS float* cum = dtl + 256;
    if (tid < 256) { const int h2 = tid >> 7, l = tid & 127; const int hx = 4 * g + 2 * hp + h2; dtl[tid] = ((const float*)(ws + WS_DTL))[(t0 + l) * 8 + hx]; cum[tid] = ((const float*)(ws + WS_CUM))[(t0 + l) * 8 + hx]; }
    asm volatile("s_waitcnt vmcnt(0) lgkmcnt(0)" ::: "memory"); __syncthreads();
    const int vlane = ((lane >> 4) & 1) * 32 + (lane & 3) * 8 + (4 * hi + ((lane & 15) >> 2)) * 64;
    const int l = 32 * lq + r32; const float cl = cum[hh2 * 128 + l];
    bf16x8 cf[8];
#pragma unroll
    for (int ks = 0; ks < 8; ++ks) cf[ks] = *(const DA_LAS bf16x8*)(lds + CC_OFF + (2 * ks + hi) * 2048 + (32 * lq + r32) * 16);
    f32x16 accd[2], acco[2];
#pragma unroll
    for (int pb = 0; pb < 2; ++pb) { accd[pb] = f32x16{}; acco[pb] = f32x16{}; }
    for (int sb = 0; sb <= lq; ++sb) {
        f32x16 gt = f32x16{};
#pragma unroll
        for (int ks = 0; ks < 8; ++ks) { const bf16x8 bfr = *(const DA_LAS bf16x8*)(lds + BC_OFF + (2 * ks + hi) * 2048 + (32 * sb + r32) * 16);
            gt = __builtin_amdgcn_mfma_f32_32x32x16_bf16(bfr, cf[ks], gt, 0, 0, 0); }
        unsigned mw[8];
#pragma unroll
        for (int r = 0; r < 16; r += 2) { const int s0 = 32 * sb + crow(r, hi), s1 = s0 + 1;
            const float e0 = (s0 <= l) ? cl - cum[hh2 * 128 + s0] : -INFINITY, e1 = (s1 <= l) ? cl - cum[hh2 * 128 + s1] : -INFINITY;
            mw[r >> 1] = cvtpk(gt[r] * __expf(e0) * dtl[hh2 * 128 + s0], gt[r + 1] * __expf(e1) * dtl[hh2 * 128 + s1]); }
#pragma unroll
        for (int ks2 = 0; ks2 < 2; ++ks2) { const u32x4_t x = {mw[4 * ks2], mw[4 * ks2 + 1], mw[4 * ks2 + 2], mw[4 * ks2 + 3]}; const bf16x8 mb = __builtin_bit_cast(bf16x8, x);
#pragma unroll
            for (int pb = 0; pb < 2; ++pb) { const bf16x8 xa = trfrag(lds + XS_OFF + ((2 * sb + ks2) * 4 + hh2 * 2 + pb) * 1024, vlane);
                accd[pb] = __builtin_amdgcn_mfma_f32_32x32x16_bf16(xa, mb, accd[pb], 0, 0, 0); } }
    }
#pragma unroll
    for (int ks = 0; ks < 8; ++ks)
#pragma unroll
        for (int pb = 0; pb < 2; ++pb) { const bf16x8 ha = *(const DA_LAS bf16x8*)(lds + HIN_OFF + hh2 * 16384 + (2 * ks + hi) * 1024 + (32 * pb + r32) * 16);
            acco[pb] = __builtin_amdgcn_mfma_f32_32x32x16_bf16(ha, cf[ks], acco[pb], 0, 0, 0); }
    const float ec = __expf(cl), dsk = F.a->in[15][h]; const size_t t = t0 + l;
    const bf16_t* zrow = (const bf16_t*)(ws + WS_ZX) + t * NP + CZ + h * 64; bf16_t* yrow = (bf16_t*)(ws + WS_Y) + t * DM + h * 64;
    float ssq = 0.f;
#pragma unroll
    for (int pb = 0; pb < 2; ++pb)
#pragma unroll
        for (int i = 0; i < 4; ++i) { const int p0 = 32 * pb + 8 * i + 4 * hi; const int colx = hh2 * 64 + p0;
            const u32x2_t xr = *(const DA_LAS u32x2_t*)(lds + XS_OFF + ((l >> 4) * 4 + (colx >> 5)) * 1024 + (l & 15) * 64 + (colx & 31) * 2);
            const uint2 zr = *(const uint2*)(zrow + p0);
            const float xv[4] = {__uint_as_float(xr.x << 16), __uint_as_float(xr.x & 0xffff0000u), __uint_as_float(xr.y << 16), __uint_as_float(xr.y & 0xffff0000u)};
            const float zv[4] = {__uint_as_float(zr.x << 16), __uint_as_float(zr.x & 0xffff0000u), __uint_as_float(zr.y << 16), __uint_as_float(zr.y & 0xffff0000u)};
            float vv[4];
#pragma unroll
            for (int e = 0; e < 4; ++e) { const float y = accd[pb][4 * i + e] + ec * acco[pb][4 * i + e] + dsk * xv[e]; vv[e] = y * silu_f(zv[e]); ssq += vv[e] * vv[e]; }
            uint2 o; o.x = pk2(vv[0], vv[1]); o.y = pk2(vv[2], vv[3]); *(uint2*)(yrow + p0) = o; }
    ssq = swap_sum(ssq);
    if (hi == 0) ((float*)(ws + WS_SSQ))[t * 8 + h] = ssq;
    __syncthreads();
}
}
__device__ __forceinline__ void phase_ssd_a(Frame& F) { for (int u = blockIdx.x; u < BATCH * NCH * 2; u += gridDim.x) ssd::pass_a(F, (DA_LAS unsigned char*)F.lds, u >> 5, (u >> 1) & 15, u & 1); }
__device__ __forceinline__ void phase_ssd_scan(Frame& F) { for (int u = blockIdx.x; u < 256; u += gridDim.x) ssd::scan_item(F, u >> 2, u & 3); }
__device__ __forceinline__ void phase_ssd_b(Frame& F) { for (int u = blockIdx.x; u < BATCH * NCH * 4; u += gridDim.x) ssd::pass_b(F, (DA_LAS unsigned char*)F.lds, u >> 6, (u >> 2) & 15, (u >> 1) & 1, u & 1); }

__device__ __forceinline__ void phase_cross_attn(Frame& F) {
    float* Ks = (float*)F.lds; float* Vs = (float*)(F.lds + 32768);
    const bf16_t* QM = (const bf16_t*)(F.a->ws + WS_QM); const bf16_t* KVM = (const bf16_t*)(F.a->ws + WS_KVM); bf16_t* OM = (bf16_t*)(F.a->ws + WS_OM);
    const int row = F.tid >> 3, sub = F.tid & 7;
    const int NU = BATCH * MH * (SEQ / 64);
    for (int uu = blockIdx.x; uu < NU; uu += gridDim.x) {
        const int qblk = uu & 31, hd = (uu >> 5) & 3, b = uu >> 7; const size_t tq = (size_t)b * SEQ + qblk * 64 + row;
        float q[32], o[32];
#pragma unroll
        for (int i = 0; i < 32; ++i) { q[i] = bf2f(QM[tq * DM + hd * 256 + sub * 32 + i]); o[i] = 0.f; }
        float mrun = -INFINITY, lrun = 0.f;
        for (int kt = 0; kt < 8; ++kt) {
            __syncthreads();
            for (int e = F.tid; e < 8192; e += NTHREADS) { const int j = e >> 8, d = e & 255; const size_t r = ((size_t)b * MEM_LEN + kt * 32 + j) * 2048;
                Ks[e] = bf2f(KVM[r + hd * 256 + d]); Vs[e] = bf2f(KVM[r + 1024 + hd * 256 + d]); }
            __syncthreads();
            _Pragma("unroll 1") for (int jb = 0; jb < 4; ++jb) {
                float s[8];
#pragma unroll
                for (int jj = 0; jj < 8; ++jj) { const float* kr = Ks + (jb * 8 + jj) * 256 + sub * 32; float a = 0.f;
#pragma unroll
                    for (int i = 0; i < 32; ++i) a += q[i] * kr[i];
                    a += __shfl_xor(a, 1); a += __shfl_xor(a, 2); a += __shfl_xor(a, 4); s[jj] = a; }
                float mx = s[0];
#pragma unroll
                for (int jj = 1; jj < 8; ++jj) mx = fmaxf(mx, s[jj]);
                const float mnew = fmaxf(mrun, mx); const float alpha = exp2f(mrun - mnew); lrun *= alpha;
#pragma unroll
                for (int i = 0; i < 32; ++i) o[i] *= alpha;
#pragma unroll
                for (int jj = 0; jj < 8; ++jj) { const float p = exp2f(s[jj] - mnew); lrun += p; const float* vr = Vs + (jb * 8 + jj) * 256 + sub * 32;
#pragma unroll
                    for (int i = 0; i < 32; ++i) o[i] += p * vr[i]; }
                mrun = mnew;
            }
        }
        const float il = 1.f / lrun; bf16_t* dst = OM + tq * DM + hd * 256 + sub * 32;
#pragma unroll
        for (int i = 0; i < 32; i += 2) *(unsigned*)(dst + i) = pk2(o[i] * il, o[i + 1] * il);
    }
    __syncthreads();
}

namespace xattn {
using dattn::f32x16; using dattn::s16x4; using dattn::crow; using dattn::cvtpk; using dattn::vtr; using dattn::swap_max; using dattn::swap_sum;
constexpr int RB = 65536, STG_OFF = 131072;
__device__ __forceinline__ void unit(Frame& F, DA_LAS unsigned char* lds, int b, int hd, int qb) {
    const int tid = F.tid, lane = tid & 63, r32 = lane & 31, hi = lane >> 5; const int wid = __builtin_amdgcn_readfirstlane(tid >> 6);
    const bf16_t* QM = (const bf16_t*)(F.a->ws + WS_QM); const bf16_t* KVM = (const bf16_t*)(F.a->ws + WS_KVM); bf16_t* OM = (bf16_t*)(F.a->ws + WS_OM);
    const size_t krow0 = (size_t)b * MEM_LEN;
#define XA_DMA_K(hf, rg) do { _Pragma("unroll") for (int i_ = 0; i_ < 8; ++i_) { const int p_ = wid * 8 + i_, c_ = p_ >> 1, kb_ = p_ & 1; \
        __builtin_amdgcn_global_load_lds((const unsigned*)(KVM + (krow0 + 128 * (hf) + 64 * kb_ + lane) * 2048 + hd * 256 + c_ * 8), (DA_LAS unsigned*)(lds + (rg) * RB + c_ * 2048 + kb_ * 1024), 16, 0, 0); } } while (0)
#define XA_DMA_V(hf, rg) do { _Pragma("unroll") for (int i_ = 0; i_ < 8; ++i_) { const int p_ = wid * 8 + i_, db_ = p_ >> 3, kg_ = p_ & 7; \
        __builtin_amdgcn_global_load_lds((const unsigned*)(KVM + (krow0 + 128 * (hf) + 16 * kg_ + (lane >> 2)) * 2048 + 1024 + hd * 256 + 32 * db_ + (lane & 3) * 8), (DA_LAS unsigned*)(lds + (rg) * RB + p_ * 1024), 16, 0, 0); } } while (0)
    XA_DMA_K(0, 0); XA_DMA_K(1, 1);
    const size_t tok = (size_t)b * SEQ + qb * 256 + wid * 32;
    const bf16_t* Qw = QM + (tok + r32) * DM + hd * 256 + hi * 8;
    bf16x8 qf[16];
#pragma unroll
    for (int ks = 0; ks < 16; ++ks) qf[ks] = *(const bf16x8*)(Qw + ks * 16);
    f32x16 sacc[8];
#pragma unroll
    for (int a = 0; a < 8; ++a) sacc[a] = f32x16{};
    asm volatile("s_waitcnt vmcnt(0)" ::: "memory"); __syncthreads();
#pragma unroll
    for (int hf = 0; hf < 2; ++hf) {
        const DA_LAS unsigned char* kb = lds + hf * RB + hi * 2048 + r32 * 16;
#pragma unroll
        for (int ks = 0; ks < 16; ++ks) {
#pragma unroll
            for (int blk = 0; blk < 4; ++blk) { const bf16x8 kf = *(const DA_LAS bf16x8*)(kb + ks * 4096 + blk * 512);
                sacc[4 * hf + blk] = __builtin_amdgcn_mfma_f32_32x32x16_bf16(kf, qf[ks], sacc[4 * hf + blk], 0, 0, 0); }
        }
        asm volatile("s_waitcnt lgkmcnt(0)" ::: "memory"); __syncthreads();
        if (hf == 0) XA_DMA_V(0, 0); else XA_DMA_V(1, 1);
    }
    float m = sacc[0][0];
#pragma unroll
    for (int a = 0; a < 8; ++a)
#pragma unroll
        for (int r = 0; r < 16; ++r) m = fmaxf(m, sacc[a][r]);
    m = swap_max(m);
    float lsum = 0.f;
#pragma unroll
    for (int a = 0; a < 8; ++a)
#pragma unroll
        for (int r = 0; r < 16; ++r) { sacc[a][r] = __builtin_amdgcn_exp2f(sacc[a][r] - m); lsum += sacc[a][r]; }
    lsum = swap_sum(lsum); const float inv = 1.0f / lsum;
    bf16x8 pa[16];
#pragma unroll
    for (int k = 0; k < 16; ++k) { const int a = k >> 1, r0 = (k & 1) * 8;
        u32x4_t x = {cvtpk(sacc[a][r0] * inv, sacc[a][r0 + 1] * inv), cvtpk(sacc[a][r0 + 2] * inv, sacc[a][r0 + 3] * inv), cvtpk(sacc[a][r0 + 4] * inv, sacc[a][r0 + 5] * inv), cvtpk(sacc[a][r0 + 6] * inv, sacc[a][r0 + 7] * inv)};
        pa[k] = __builtin_bit_cast(bf16x8, x); }
    asm volatile("s_waitcnt vmcnt(0)" ::: "memory"); __syncthreads();
    const int vlane = ((lane >> 4) & 1) * 32 + (lane & 3) * 8 + (4 * hi + ((lane & 15) >> 2)) * 64;
    DA_LAS bf16_t* stg = (DA_LAS bf16_t*)(lds + STG_OFF + wid * 2048);
#pragma unroll 1
    for (int dh = 0; dh < 2; ++dh) {
        f32x16 o[4];
#pragma unroll
        for (int d = 0; d < 4; ++d) o[d] = f32x16{};
#pragma unroll
        for (int hf = 0; hf < 2; ++hf)
#pragma unroll
            for (int kg = 0; kg < 8; ++kg)
#pragma unroll
                for (int d = 0; d < 4; ++d) { const DA_LAS unsigned char* vp = lds + hf * RB + ((4 * dh + d) * 8 + kg) * 1024 + vlane;
                    const s16x4 lo = vtr(vp), hh = vtr(vp + 512); const bf16x8 vf = (bf16x8){lo[0], lo[1], lo[2], lo[3], hh[0], hh[1], hh[2], hh[3]};
                    o[d] = __builtin_amdgcn_mfma_f32_32x32x16_bf16(pa[8 * hf + kg], vf, o[d], 0, 0, 0); }
#pragma unroll
        for (int d = 0; d < 4; ++d) {
#pragma unroll
            for (int r = 0; r < 16; ++r) stg[crow(r, hi) * 32 + r32] = f2bf(o[d][r]);
            asm volatile("s_waitcnt lgkmcnt(0)" ::: "memory");
            const int row = lane >> 1, hb = lane & 1;
            const u32x4_t v0 = *(const DA_LAS u32x4_t*)(stg + row * 32 + hb * 16), v1 = *(const DA_LAS u32x4_t*)(stg + row * 32 + hb * 16 + 8);
            bf16_t* dst = OM + (tok + row) * DM + hd * 256 + (4 * dh + d) * 32 + hb * 16;
            *(u32x4_t*)dst = v0; *(u32x4_t*)(dst + 8) = v1;
            asm volatile("s_waitcnt lgkmcnt(0)" ::: "memory");
        }
    }
    __syncthreads();
#undef XA_DMA_K
#undef XA_DMA_V
}
}
__device__ __forceinline__ void phase_cross_attn_mfma(Frame& F) {
    const int G = gridDim.x, bx = blockIdx.x; const int vcu = (G % 8 == 0) ? (bx % 8) * (G / 8) + bx / 8 : bx;
    for (int v = vcu; v < 256; v += G) xattn::unit(F, (DA_LAS unsigned char*)F.lds, v >> 5, (v >> 3) & 3, v & 7);
}

__device__ __forceinline__ void phase_resid_norm(Frame& F, const float* T, const float* base, const float* g_post, float* xo, const float* g_next, bf16_t* XN) {
    for (int m = F.gw; m < M; m += F.ngw) {
        const f32x4* tr = (const f32x4*)(T + (size_t)m * DM) + F.lane; const f32x4* br = (const f32x4*)(base + (size_t)m * DM) + F.lane;
        f32x4 v[4]; float s = 0.f;
#pragma unroll
        for (int j = 0; j < 4; ++j) { v[j] = tr[64 * j]; s += (v[j].x * v[j].x + v[j].y * v[j].y) + (v[j].z * v[j].z + v[j].w * v[j].w); }
        const float r = 1.0f / sqrtf(wave_sum(s) * (1.f / DM) + EPS); float s2 = 0.f;
#pragma unroll
        for (int j = 0; j < 4; ++j) { const f32x4 g = *((const f32x4*)g_post + F.lane + 64 * j); v[j] = br[64 * j] + v[j] * r * g; *((f32x4*)(xo + (size_t)m * DM) + F.lane + 64 * j) = v[j];
            s2 += (v[j].x * v[j].x + v[j].y * v[j].y) + (v[j].z * v[j].z + v[j].w * v[j].w); }
        if (XN) { const float r2 = 1.0f / sqrtf(wave_sum(s2) * (1.f / DM) + EPS);
#pragma unroll
            for (int j = 0; j < 4; ++j) { const f32x4 g = *((const f32x4*)g_next + F.lane + 64 * j); const f32x4 w = v[j] * r2 * g; uint2 o; o.x = pk2(w.x, w.y); o.y = pk2(w.z, w.w); *((uint2*)(XN + (size_t)m * DM) + F.lane + 64 * j) = o; } }
    }
}

#define GAS __attribute__((address_space(1)))
#define LAS __attribute__((address_space(3)))
typedef GAS unsigned gu32;
typedef GAS unsigned long long gu64;
#define RLX_AGENT __ATOMIC_RELAXED, __HIP_MEMORY_SCOPE_AGENT
#define XB_TMO      128
#define XB_XCNT(j)  (256  + 64 * (j))
#define XB_XSUB(j)  (1280 + 64 * (j))
#define XB_XGEN(j)  (2304 + 64 * (j))
#define XB_TOP      3328
#define XB_TOPGEN   3392
#define XCD_BAR_WORDS 3456
#define XB_SPIN_CAP (1u << 18)

__device__ __forceinline__ unsigned xb_ld(unsigned* p)              { return __hip_atomic_load(p, __ATOMIC_RELAXED, __HIP_MEMORY_SCOPE_AGENT); }
__device__ __forceinline__ unsigned xb_add(unsigned* p, unsigned v) { return __hip_atomic_fetch_add(p, v, __ATOMIC_RELAXED, __HIP_MEMORY_SCOPE_AGENT); }
__device__ __forceinline__ unsigned xb_xcc_id() { return (unsigned)__builtin_amdgcn_s_getreg((3 << 11) | 20) & 0xFu; }
#define XB_SPIN(cond, bar) do { unsigned _sp = 0; while (cond) { __builtin_amdgcn_s_sleep(1); \
    if ((++_sp & 255u) == 0u) { if (xb_ld(&(bar)[XB_TMO])) break; if (_sp > XB_SPIN_CAP) { atomicAdd(&(bar)[XB_TMO], 1u); break; } } } } while (0)

struct XcdBarrier {
    unsigned* bar; unsigned x;
    volatile LAS unsigned* st;
};

__device__ __forceinline__ XcdBarrier xcd_barrier_post(unsigned* bar, volatile LAS unsigned* st) {
    XcdBarrier b; b.bar = bar; b.x = xb_xcc_id(); b.st = st;
    if (threadIdx.x == 0) (void)xb_add(&bar[XB_XCNT(b.x)], 1u);
    return b;
}
__device__ __forceinline__ void xcd_barrier_complete(unsigned* bar, unsigned x, unsigned& nloc, unsigned& nx) {
    const unsigned G = gridDim.x * gridDim.y * gridDim.z;
    unsigned sum, cnt, mine, sp = 0u;
    for (;;) {
        sum = 0u; cnt = 0u; mine = 0u;
#pragma unroll
        for (unsigned j = 0; j < 16; ++j) { const unsigned c = xb_ld(&bar[XB_XCNT(j)]); sum += c; cnt += (c > 0u) ? 1u : 0u; mine = (j == x) ? c : mine; }
        if (sum == G) break;
        __builtin_amdgcn_s_sleep(1);
        if ((++sp & 255u) == 0u) { if (xb_ld(&bar[XB_TMO])) break; if (sp > XB_SPIN_CAP) { atomicAdd(&bar[XB_TMO], 1u); break; } }
    }
    nloc = mine > 0u ? mine : 1u; nx = cnt > 0u ? cnt : 1u;
}

__device__ __forceinline__ void xcd_barrier(const XcdBarrier& b) {
    asm volatile("s_waitcnt vmcnt(0)" ::: "memory");
    __syncthreads();
    if (threadIdx.x == 0) {
        unsigned* bar = b.bar;
        __builtin_amdgcn_s_waitcnt(0);
        unsigned nloc = b.st[0], nx = b.st[1];
        if (nloc == 0u) { xcd_barrier_complete(bar, b.x, nloc, nx); b.st[0] = nloc; b.st[1] = nx; }
        const unsigned old = xb_add(&bar[XB_XSUB(b.x)], 1u);
        const unsigned gen = old / nloc;
        if (old + 1u == (gen + 1u) * nloc) {
            __builtin_amdgcn_fence(__ATOMIC_RELEASE, "agent");
            asm volatile("s_waitcnt vmcnt(0)" ::: "memory");
            const unsigned og = xb_add(&bar[XB_TOP], 1u);
            const unsigned tg = og / nx;
            if (og + 1u == (tg + 1u) * nx) xb_add(&bar[XB_TOPGEN], 1u);
            else XB_SPIN(xb_ld(&bar[XB_TOPGEN]) == tg, bar);
            __builtin_amdgcn_fence(__ATOMIC_ACQUIRE, "agent");
            xb_add(&bar[XB_XGEN(b.x)], 1u);
            asm volatile("s_waitcnt vmcnt(0)" ::: "memory");
        } else {
            XB_SPIN(xb_ld(&bar[XB_XGEN(b.x)]) == gen, bar);
            __builtin_amdgcn_fence(__ATOMIC_ACQUIRE, "agent");
            asm volatile("s_waitcnt vmcnt(0)" ::: "memory");
        }
    }
    __syncthreads();
}
constexpr int NPHASE = 16;
__global__ void __launch_bounds__(NTHREADS, 2) mk_fwd(Args args) {
    extern __shared__ __attribute__((aligned(16))) unsigned char lds[];
    Frame F; F.lds = lds; F.tid = threadIdx.x; F.lane = F.tid & 63; F.wave = F.tid >> 6; F.gw = blockIdx.x * 8 + F.wave; F.ngw = gridDim.x * 8; F.a = &args;
    unsigned char* ws = args.ws;
    bf16_t* XN = (bf16_t*)(ws + WS_XN);
#if MK_SINGLE
    volatile LAS unsigned* MISC = (volatile LAS unsigned*)((LAS unsigned char*)lds + MISC_OFF);
    if (F.tid < 64) MISC[F.tid] = 0u;
    __syncthreads();
    XcdBarrier bar = xcd_barrier_post((unsigned*)(ws + WS_CTL) + 1024, MISC + 8);
#endif
    const int lo = args.ph_lo, hi = args.ph_hi;
#ifdef ONLY
#define IN(k) ((k) == ONLY && lo <= (k) && (k) < hi)
#elif defined(PMASK)
#define IN(k) (((PMASK >> (k)) & 1) && lo <= (k) && (k) < hi)
#else
#define IN(k) (lo <= (k) && (k) < hi)
#endif
#if MK_SINGLE
#define SEAM(k) do { if ((k) + 1 < hi) xcd_barrier(bar); } while (0)
#else
#define SEAM(k) do { } while (0)
#endif
#define PG8_RUN(Aptr, Btptr, Mr, Nc, Kk, EPI) do { pg8::Gemm g_{(const bf16_t*)(Aptr), (const bf16_t*)(Btptr), (Mr), (Nc), (Kk)}; pg8::StaticOrder S_; S_.init((Mr), (Nc), (int)gridDim.x, (int)blockIdx.x); \
        auto e_ = (EPI); pg8::EpiGen<decltype(e_)> E_{e_}; pg8::gemm_phase<pg8::EpiGen<decltype(e_)>, pg8::StaticOrder, PG8_ALIGN, PG8_SP2>((PG8_LAS unsigned char*)lds, g_, S_, E_); } while (0)
    if (IN(0)) { phase_prologue(F); SEAM(0); }
    if (IN(1)) { PG8_RUN(XN, ws + WS_WIN, M, NP, DM, (EpiBf16{(bf16_t*)(ws + WS_ZX), NP, 1.f}));
                 PG8_RUN(ws + WS_MEMH, ws + WS_WMKV, MM, 2048, DM, (EpiBf16{(bf16_t*)(ws + WS_KVM), 2048, 1.f})); SEAM(1); }
    if (IN(2)) { phase_rope(F); SEAM(2); }
    if (IN(3)) { phase_ssd_a(F); SEAM(3); phase_ssd_scan(F); SEAM(3); }
    if (IN(4)) { phase_ssd_b(F); SEAM(4); }
    if (IN(5)) { phase_ssd_norm(F); SEAM(5); }
    if (IN(6)) { phase_diff_attn_mfma(F); SEAM(6); }
    if (IN(7)) { PG8_RUN(ws + WS_Y, ws + WS_WOUT, M, DM, DM, (EpiF32{(float*)(ws + WS_T), DM})); SEAM(7); }
    if (IN(8)) { phase_resid_norm(F, (const float*)(ws + WS_T), args.in[0], args.in[4], args.out, args.in[5], XN); SEAM(8); }
    if (IN(9)) { PG8_RUN(XN, ws + WS_WMQ, M, DM, DM, (EpiBf16{(bf16_t*)(ws + WS_QM), DM, C2_MEM})); SEAM(9); }
    if (IN(10)) { phase_cross_attn_mfma(F); SEAM(10); }
    if (IN(11)) { PG8_RUN(ws + WS_OM, ws + WS_WMO, M, DM, DM, (EpiF32{(float*)(ws + WS_T), DM})); SEAM(11); }
    if (IN(12)) { phase_resid_norm(F, (const float*)(ws + WS_T), args.out, args.in[7], args.out, args.in[8], XN); SEAM(12); }
    if (IN(13)) { PG8_RUN(XN, ws + WS_WUP, M, DFF, DM, (EpiRelu2{(bf16_t*)(ws + WS_H), DFF})); SEAM(13); }
    if (IN(14)) { PG8_RUN(ws + WS_H, ws + WS_WDN, M, DM, DFF, (EpiF32{(float*)(ws + WS_T2), DM})); SEAM(14); }
    if (IN(15)) { phase_resid_norm(F, (const float*)(ws + WS_T2), args.out, args.in[9], args.out, nullptr, nullptr); }
#undef IN
#undef SEAM
}

extern "C" void kernel_launch(void* const* d_in, const int* in_sizes, int n_in, void* d_out, int out_size, void* d_ws, size_t ws_size, hipStream_t stream) {
    static int grid = 0;
    if (grid == 0) {
        if (n_in != 29 || out_size != M * DM || ws_size < WS_END) { fprintf(stderr, "kernel_launch: unexpected shapes n_in %d out %d ws %zu\n", n_in, out_size, ws_size); grid = -1; return; }
        int dev = 0, cus = 0, per_cu = 0;
        hipGetDevice(&dev); hipDeviceGetAttribute(&cus, hipDeviceAttributeMultiprocessorCount, dev);
        hipFuncSetAttribute((const void*)mk_fwd, hipFuncAttributeMaxDynamicSharedMemorySize, LDS_BYTES);
        hipOccupancyMaxActiveBlocksPerMultiprocessor(&per_cu, (const void*)mk_fwd, NTHREADS, LDS_BYTES);
        if (per_cu < 1) per_cu = 1;
        grid = cus * per_cu;
        fprintf(stderr, "kernel_launch: cus %d per_cu %d grid %d\n", cus, per_cu, grid);
    }
    if (grid < 0) return;
    Args a{};
    for (int i = 0; i < 29; ++i) a.in[i] = (const float*)d_in[i];
    a.out = (float*)d_out; a.ws = (unsigned char*)d_ws;
#if MK_SINGLE
    hipMemsetAsync((char*)d_ws + WS_CTL, 0, CTL_ZERO_BYTES, stream);
    a.ph_lo = 0; a.ph_hi = NPHASE; a.coop = 1;
    void* kargs[] = {&a};
    hipError_t e = hipLaunchCooperativeKernel((const void*)mk_fwd, dim3(grid), dim3(NTHREADS), kargs, LDS_BYTES, stream);
    if (e != hipSuccess) fprintf(stderr, "cooperative launch failed: %s (grid %d)\n", hipGetErrorString(e), grid);
#else
    for (int ph = 0; ph < NPHASE; ++ph) { a.ph_lo = ph; a.ph_hi = ph + 1; a.coop = 0; hipLaunchKernelGGL(mk_fwd, dim3(grid), dim3(NTHREADS), LDS_BYTES, stream, a); }
#endif
}
```
